# Optimizing an MI355X kernel written in HIP

```python
import math
import jax, jax.numpy as jnp
from jax import lax
import numpy as np

D_MODEL = 1024
BATCH = 32
SEQ = 2048
DEPTH = 2

N_MEM = 256
HEAD_DIM = 64
ROPE_DIM = HEAD_DIM // 4
ROPE_THETA = 500000.0
RMS_EPS = 1e-6
N_TOK_HEADS = 12
N_MEM_HEADS = 4
MIX_WIDTH = (N_TOK_HEADS + N_MEM_HEADS) * HEAD_DIM
MEM_Q = N_MEM_HEADS * HEAD_DIM
D_FF = ((8 * D_MODEL // 3 + 255) // 256) * 256
Q_BLOCK = 128

DSA_KV_RANK = 128
DSA_NOPE = HEAD_DIM - ROPE_DIM
IDX_HEADS = 8
IDX_DIM = 64
DSA_TOPK_MAX = 256
DSA_COLS = [N_TOK_HEADS * HEAD_DIM, DSA_KV_RANK, ROPE_DIM,
            IDX_HEADS * IDX_DIM, IDX_DIM, IDX_HEADS, MEM_Q]

NSA_GROUPS = 2
NSA_HPG = N_TOK_HEADS // NSA_GROUPS
CMP_LEN = 32
CMP_STRIDE = 16
CMP_HIDDEN = 128
SLC_LEN = 64
SLC_TOP_MAX = 16
WIN = 512
NSA_Q_BLOCK = 64
FORCE_SCORE = 1e9
NSA_KV = NSA_GROUPS * HEAD_DIM
NSA_COLS = [N_TOK_HEADS * HEAD_DIM, NSA_KV, NSA_KV, NSA_KV, NSA_KV, NSA_KV, NSA_KV,
            N_TOK_HEADS * 3, MEM_Q]

N_A = (DEPTH + 1) // 2
N_B = DEPTH // 2

kernel_name = "hybrid_dsa_nsa_memory_trunk"


def split_cols(x, sizes):
    return jnp.split(x, np.cumsum(sizes)[:-1].tolist(), axis=-1)


def rmsnorm(x, g):
    xf = x.astype(jnp.float32)
    y = xf * lax.rsqrt(jnp.mean(xf * xf, axis=-1, keepdims=True) + RMS_EPS)
    return (y * g.astype(jnp.float32)).astype(x.dtype)


def rope_tables(S):
    inv = ROPE_THETA ** (-np.arange(0, ROPE_DIM, 2, dtype=np.float64) / ROPE_DIM)
    ang = np.arange(S, dtype=np.float64)[:, None] * inv[None, :]
    return jnp.asarray(np.cos(ang).astype(np.float32)), jnp.asarray(np.sin(ang).astype(np.float32))


def apply_partial_rope(x, cos, sin):
    xr, xp = x[..., :ROPE_DIM], x[..., ROPE_DIM:]
    x1, x2 = xr[..., :ROPE_DIM // 2], xr[..., ROPE_DIM // 2:]
    c, s = cos[:, None, :], sin[:, None, :]
    rot = jnp.concatenate([x1 * c - x2 * s, x1 * s + x2 * c], axis=-1).astype(x.dtype)
    return jnp.concatenate([rot, xp], axis=-1)


def masked_softmax(s, mask):
    s = jnp.where(mask, s.astype(jnp.float32), -jnp.inf)
    m = jnp.max(s, axis=-1, keepdims=True)
    m = jnp.where(jnp.isfinite(m), m, 0.0)
    p = jnp.exp(s - m)
    return p / jnp.maximum(jnp.sum(p, axis=-1, keepdims=True), 1e-30)


def memory_attention(q_mem, mem_n, w_kv_mem):
    B, S, _ = q_mem.shape
    q = q_mem.reshape(B, S, N_MEM_HEADS, HEAD_DIM)
    k, v = jnp.split(mem_n @ w_kv_mem, 2, axis=-1)
    k = k.reshape(B, -1, N_MEM_HEADS, HEAD_DIM)
    v = v.reshape(B, -1, N_MEM_HEADS, HEAD_DIM)
    s = jnp.einsum('bshd,bnhd->bhsn', q, k).astype(jnp.float32) * HEAD_DIM ** -0.5
    p = jax.nn.softmax(s, axis=-1).astype(v.dtype)
    return jnp.einsum('bhsn,bnhd->bshd', p, v).reshape(B, S, MEM_Q)


def dsa_mixer(cols, ckv_norm, w_uk, w_uv, cos, sin):
    q, ckv, k_rope, q_idx, k_idx, w_idx = cols
    B, S, _ = q.shape
    q = apply_partial_rope(q.reshape(B, S, N_TOK_HEADS, HEAD_DIM), cos, sin)
    ckv = rmsnorm(ckv, ckv_norm)
    k_nope = ckv @ w_uk
    v = ckv @ w_uv
    k_r = apply_partial_rope(k_rope[:, :, None, :], cos, sin)[:, :, 0]
    k = jnp.concatenate([k_r, k_nope], axis=-1)
    q_idx = apply_partial_rope(q_idx.reshape(B, S, IDX_HEADS, IDX_DIM), cos, sin)
    k_idx = apply_partial_rope(k_idx[:, :, None, :], cos, sin)[:, :, 0]
    w_idx = w_idx.astype(jnp.float32) * (IDX_HEADS ** -0.5 * IDX_DIM ** -0.5)
    topk = min(DSA_TOPK_MAX, S // 4)
    key_pos = jnp.arange(S)
    gather = jax.vmap(lambda kb, ib: kb[ib])

    def block(i):
        t0 = i * Q_BLOCK
        qpos = t0 + jnp.arange(Q_BLOCK)
        qi = lax.dynamic_slice_in_dim(q, t0, Q_BLOCK, axis=1)
        qii = lax.dynamic_slice_in_dim(q_idx, t0, Q_BLOCK, axis=1)
        wi = lax.dynamic_slice_in_dim(w_idx, t0, Q_BLOCK, axis=1)
        logits = jnp.einsum('bthd,bsd->bths', qii, k_idx).astype(jnp.float32)
        score = jnp.einsum('bths,bth->bts', jax.nn.relu(logits), wi)
        causal = key_pos[None, :] <= qpos[:, None]
        score = jnp.where(causal[None], score, -jnp.inf)
        _, idx = lax.top_k(score, topk)
        k_sel = gather(k, idx)
        v_sel = gather(v, idx)
        valid = idx <= qpos[None, :, None]
        s = jnp.einsum('bthd,btkd->bthk', qi, k_sel) * HEAD_DIM ** -0.5
        p = masked_softmax(s, valid[:, :, None, :]).astype(v.dtype)
        return jnp.einsum('bthk,btkd->bthd', p, v_sel).reshape(B, Q_BLOCK, N_TOK_HEADS * HEAD_DIM)

    out = lax.map(block, jnp.arange(S // Q_BLOCK))
    return out.transpose(1, 0, 2, 3).reshape(B, S, N_TOK_HEADS * HEAD_DIM)


def cmp_to_slc_overlap(n_c, n_slc):
    c0 = np.arange(n_c) * CMP_STRIDE
    s0 = np.arange(n_slc) * SLC_LEN
    ov = np.minimum(c0[:, None] + CMP_LEN, s0[None, :] + SLC_LEN) - np.maximum(c0[:, None], s0[None, :])
    return jnp.asarray((np.clip(ov, 0, None) / CMP_LEN).astype(np.float32))


def compress(kv, pos_emb, w1, w2):
    B, S, G, Dh = kv.shape
    n_c = (S - CMP_LEN) // CMP_STRIDE + 1
    blk = np.arange(n_c)[:, None] * CMP_STRIDE + np.arange(CMP_LEN)[None, :]
    blocks = kv[:, blk] + pos_emb[None, None, :, None, :]
    flat = blocks.transpose(0, 1, 3, 2, 4).reshape(B, n_c, G, CMP_LEN * Dh)
    return jax.nn.gelu(flat @ w1) @ w2


def nsa_mixer(cols, pos_k, pos_v, ck_w1, ck_w2, cv_w1, cv_w2, cos, sin):
    q, kc, vc, ks, vs, kw, vw, gates = cols
    B, S, _ = q.shape
    G, J, Dh = NSA_GROUPS, NSA_HPG, HEAD_DIM
    q = q.reshape(B, S, N_TOK_HEADS, Dh)
    q_rot = apply_partial_rope(q, cos, sin)
    kc, vc = kc.reshape(B, S, G, Dh), vc.reshape(B, S, G, Dh)
    ks = apply_partial_rope(ks.reshape(B, S, G, Dh), cos, sin)
    vs = vs.reshape(B, S, G, Dh)
    kw = apply_partial_rope(kw.reshape(B, S, G, Dh), cos, sin)
    vw = vw.reshape(B, S, G, Dh)
    gates = jax.nn.sigmoid(gates.astype(jnp.float32)).astype(q.dtype).reshape(B, S, G, J, 3)
    scale = Dh ** -0.5

    k_cmp = compress(kc, pos_k, ck_w1, ck_w2)
    v_cmp = compress(vc, pos_v, cv_w1, cv_w2)
    n_c = k_cmp.shape[1]
    cmp_end = jnp.arange(n_c) * CMP_STRIDE + CMP_LEN - 1
    n_slc = S // SLC_LEN
    n_sel = min(SLC_TOP_MAX, n_slc)
    overlap = cmp_to_slc_overlap(n_c, n_slc)
    slc_ids = jnp.arange(n_slc)
    ks_b = ks.reshape(B, n_slc, SLC_LEN, G, Dh).transpose(0, 3, 1, 2, 4)
    vs_b = vs.reshape(B, n_slc, SLC_LEN, G, Dh).transpose(0, 3, 1, 2, 4)
    gather = jax.vmap(jax.vmap(lambda kb, ib: kb[ib]))
    kw_pad = jnp.pad(kw, ((0, 0), (WIN, 0), (0, 0), (0, 0)))
    vw_pad = jnp.pad(vw, ((0, 0), (WIN, 0), (0, 0), (0, 0)))

    def block(i):
        T = NSA_Q_BLOCK
        t0 = i * T
        qpos = t0 + jnp.arange(T)
        qc = lax.dynamic_slice_in_dim(q, t0, T, axis=1).reshape(B, T, G, J, Dh)
        qr = lax.dynamic_slice_in_dim(q_rot, t0, T, axis=1).reshape(B, T, G, J, Dh)
        gi = lax.dynamic_slice_in_dim(gates, t0, T, axis=1)
        s_c = jnp.einsum('btgjd,bcgd->btgjc', qc, k_cmp) * scale
        mask_c = cmp_end[None, :] <= qpos[:, None]
        p_c = masked_softmax(s_c, mask_c[None, :, None, None, :])
        o_c = jnp.einsum('btgjc,bcgd->btgjd', p_c.astype(v_cmp.dtype), v_cmp)
        imp = jnp.einsum('btgjc,cn->btgn', p_c, overlap)
        cur = qpos // SLC_LEN
        forced = (slc_ids[None] == 0) | (slc_ids[None] == cur[:, None]) | (slc_ids[None] == cur[:, None] - 1)
        admissible = slc_ids[None] <= cur[:, None]
        imp = jnp.where(forced[None, :, None, :], FORCE_SCORE, imp)
        imp = jnp.where(admissible[None, :, None, :], imp, -jnp.inf)
        _, sel = lax.top_k(imp, n_sel)
        sel_g = sel.transpose(0, 2, 1, 3)
        k_sel = gather(ks_b, sel_g).reshape(B, G, T, n_sel * SLC_LEN, Dh)
        v_sel = gather(vs_b, sel_g).reshape(B, G, T, n_sel * SLC_LEN, Dh)
        tok_pos = (sel_g[..., None] * SLC_LEN + jnp.arange(SLC_LEN)).reshape(B, G, T, n_sel * SLC_LEN)
        mask_s = tok_pos <= qpos[None, None, :, None]
        s_s = jnp.einsum('btgjd,bgtkd->bgtjk', qr, k_sel) * scale
        p_s = masked_softmax(s_s, mask_s[:, :, :, None, :]).astype(v_sel.dtype)
        o_s = jnp.einsum('bgtjk,bgtkd->btgjd', p_s, v_sel)
        kw_i = lax.dynamic_slice_in_dim(kw_pad, t0, WIN + T, axis=1)
        vw_i = lax.dynamic_slice_in_dim(vw_pad, t0, WIN + T, axis=1)
        kpos = t0 - WIN + jnp.arange(WIN + T)
        mask_w = (kpos[None] <= qpos[:, None]) & (kpos[None] > qpos[:, None] - WIN) & (kpos[None] >= 0)
        s_w = jnp.einsum('btgjd,bkgd->btgjk', qr, kw_i) * scale
        p_w = masked_softmax(s_w, mask_w[None, :, None, None, :]).astype(vw_i.dtype)
        o_w = jnp.einsum('btgjk,bkgd->btgjd', p_w, vw_i)
        o = gi[..., 0:1] * o_c + gi[..., 1:2] * o_s + gi[..., 2:3] * o_w
        return o.reshape(B, T, N_TOK_HEADS * Dh)

    out = lax.map(block, jnp.arange(S // NSA_Q_BLOCK))
    return out.transpose(1, 0, 2, 3).reshape(B, S, N_TOK_HEADS * HEAD_DIM)


def setup_inputs(seed: int = 0) -> dict:
    key = jax.random.key(seed)
    ks = jax.random.split(key, 24)

    def w(k, shape, fan_in):
        return jax.random.normal(k, shape, jnp.float32) * fan_in ** -0.5

    def gain(k, shape):
        return 1.0 + 0.02 * jax.random.normal(k, shape, jnp.float32)

    return {
        "x": jax.random.normal(ks[0], (BATCH, SEQ, D_MODEL), jnp.float32),
        "mem": jax.random.normal(ks[1], (BATCH, N_MEM, D_MODEL), jnp.float32),
        "attn_norm": gain(ks[2], (DEPTH, D_MODEL)),
        "mem_norm": gain(ks[3], (DEPTH, D_MODEL)),
        "ffn_norm": gain(ks[4], (DEPTH, D_MODEL)),
        "final_norm": gain(ks[5], (D_MODEL,)),
        "dsa_w_in": w(ks[6], (N_A, D_MODEL, sum(DSA_COLS)), D_MODEL),
        "dsa_ckv_norm": gain(ks[7], (N_A, DSA_KV_RANK)),
        "dsa_w_uk": w(ks[8], (N_A, DSA_KV_RANK, DSA_NOPE), DSA_KV_RANK),
        "dsa_w_uv": w(ks[9], (N_A, DSA_KV_RANK, HEAD_DIM), DSA_KV_RANK),
        "nsa_w_in": w(ks[10], (N_B, D_MODEL, sum(NSA_COLS)), D_MODEL),
        "nsa_cmp_pos_k": 0.1 * jax.random.normal(ks[11], (N_B, CMP_LEN, HEAD_DIM), jnp.float32),
        "nsa_cmp_pos_v": 0.1 * jax.random.normal(ks[12], (N_B, CMP_LEN, HEAD_DIM), jnp.float32),
        "nsa_cmp_k_w1": w(ks[13], (N_B, CMP_LEN * HEAD_DIM, CMP_HIDDEN), CMP_LEN * HEAD_DIM),
        "nsa_cmp_k_w2": w(ks[14], (N_B, CMP_HIDDEN, HEAD_DIM), CMP_HIDDEN),
        "nsa_cmp_v_w1": w(ks[15], (N_B, CMP_LEN * HEAD_DIM, CMP_HIDDEN), CMP_LEN * HEAD_DIM),
        "nsa_cmp_v_w2": w(ks[16], (N_B, CMP_HIDDEN, HEAD_DIM), CMP_HIDDEN),
        "mem_w_kv": w(ks[17], (DEPTH, D_MODEL, 2 * MEM_Q), D_MODEL),
        "w_o": w(ks[18], (DEPTH, MIX_WIDTH, D_MODEL), MIX_WIDTH),
        "ffn_w_in": w(ks[19], (DEPTH, D_MODEL, 2 * D_FF), D_MODEL),
        "ffn_w_down": w(ks[20], (DEPTH, D_FF, D_MODEL), D_FF),
    }


def reference(x, mem, attn_norm, mem_norm, ffn_norm, final_norm,
              dsa_w_in, dsa_ckv_norm, dsa_w_uk, dsa_w_uv,
              nsa_w_in, nsa_cmp_pos_k, nsa_cmp_pos_v,
              nsa_cmp_k_w1, nsa_cmp_k_w2, nsa_cmp_v_w1, nsa_cmp_v_w2,
              mem_w_kv, w_o, ffn_w_in, ffn_w_down):
    S = x.shape[1]
    cos, sin = rope_tables(S)
    for i in range(DEPTH):
        h = rmsnorm(x, attn_norm[i])
        mem_n = rmsnorm(mem, mem_norm[i])
        if i % 2 == 0:
            a = i // 2
            cols = split_cols(h @ dsa_w_in[a], DSA_COLS)
            q_mem = cols[-1]
            tok = dsa_mixer(cols[:-1], dsa_ckv_norm[a], dsa_w_uk[a], dsa_w_uv[a], cos, sin)
        else:
            b = i // 2
            cols = split_cols(h @ nsa_w_in[b], NSA_COLS)
            q_mem = cols[-1]
            tok = nsa_mixer(cols[:-1], nsa_cmp_pos_k[b], nsa_cmp_pos_v[b],
                            nsa_cmp_k_w1[b], nsa_cmp_k_w2[b], nsa_cmp_v_w1[b], nsa_cmp_v_w2[b],
                            cos, sin)
        o_mem = memory_attention(q_mem, mem_n, mem_w_kv[i])
        x = x + jnp.concatenate([tok, o_mem], axis=-1) @ w_o[i]
        h = rmsnorm(x, ffn_norm[i])
        g, u = jnp.split(h @ ffn_w_in[i], 2, axis=-1)
        x = x + (jax.nn.silu(g) * u) @ ffn_w_down[i]
    return rmsnorm(x, final_norm)
```

```cpp
#include <hip/hip_runtime.h>
#include <hip/hip_bf16.h>
#include <cstdio>
#include <cstdint>
#include <cmath>
namespace pg8 {
#define PG8_LAS __attribute__((address_space(3)))
typedef unsigned short bf16_t;
typedef short bf16x8 __attribute__((ext_vector_type(8)));
typedef float f32x4 __attribute__((ext_vector_type(4)));
typedef unsigned u32x4 __attribute__((ext_vector_type(4)));
constexpr int BM = 256, BK = 64, HALF = 128, HTB = HALF * BK * 2  , STAGE_BYTES = 8 * HTB, NXCD = 8, WGM = 8;

__host__ __device__ __forceinline__ int lds_byte(int r, int c) { const int st = (r >> 4) * 2 + (c >> 5), rr = r & 15, cc = c & 31, ob = rr * 64 + cc * 2; return st * 1024 + (ob ^ (((ob >> 9) & 1) << 5)); }
__host__ __device__ __forceinline__ void stage_rc(int b, int& R, int& C) { const int st = b / 1024, sb = b % 1024, swz = sb ^ (((sb >> 9) & 1) << 5); R = (st >> 1) * 16 + swz / 64; C = (st & 1) * 32 + (swz % 64) / 2; }
__host__ __device__ __forceinline__ int perm32(int rho) { const int n = rho >> 4, i = rho & 15; return 8 * (i >> 2) + 4 * n + (i & 3); }

struct Unit { int pm, pn; };
struct Gemm { const bf16_t* A; const bf16_t* Bt; int M, N, K; };

struct StaticOrder {
    int nM, nN, nwg, G, c;
    __host__ __device__ void init(int M, int N, int G_, int c_) { nM = M / BM; nN = N / BM; nwg = nM * nN; G = G_; c = c_; }
    __host__ __device__ bool next(int i, Unit& u) const {
        const long L = (long)i * G + c; if (L >= nwg) return false;
        int wgid = (int)L; { const int q = nwg / NXCD, r = nwg % NXCD, xcd = wgid % NXCD, off = wgid / NXCD; wgid = (xcd < r ? xcd * (q + 1) : r * (q + 1) + (xcd - r) * q) + off; }
        const int nig = WGM * nN, gid = wgid / nig, fm = gid * WGM, gsz = (nM - fm) < WGM ? (nM - fm) : WGM;
        u.pm = fm + ((wgid % nig) % gsz); u.pn = (wgid % nig) / gsz; return true;
    }
    __device__ __forceinline__ void a_ready(const Unit&) const {}
    __device__ __forceinline__ void done(const Unit&) const {}
};
typedef float f32x2_t __attribute__((ext_vector_type(2))); typedef __bf16 bf16x2_t __attribute__((ext_vector_type(2)));
__device__ __forceinline__ unsigned cvt_pk_bf16(float lo, float hi) { f32x2_t v = {lo, hi}; bf16x2_t b = __builtin_convertvector(v, bf16x2_t); return __builtin_bit_cast(unsigned, b); }
struct EpiStoreBf16 {
    static constexpr bool PERM = true, AFTER_DRAIN = false, PRE = false;
    bf16_t* O; int ldc; const PG8_LAS float* rl; int scaled;
    __device__ __forceinline__ void operator()(const f32x4 (&acc)[2][2][4][2], const Unit& u, int wr, int wc, int fr, int fq) const {
        const int row0 = u.pm * BM + wr * 64 + fr, col0 = u.pn * BM + wc * 32 + 8 * fq;
#pragma unroll
        for (int ai = 0; ai < 2; ++ai)
#pragma unroll
            for (int m = 0; m < 4; ++m) { bf16_t* rowp = O + (size_t)(row0 + ai * HALF + m * 16) * ldc + col0;
                const float rs = scaled ? rl[((u.pm >> 3) & 3) * 256 + wr * 64 + fr + ai * HALF + m * 16] : 1.f;
#pragma unroll
                for (int bj = 0; bj < 2; ++bj) { const f32x4 v0 = acc[ai][bj][m][0] * rs, v1 = acc[ai][bj][m][1] * rs;
                    u32x4 w; w.x = cvt_pk_bf16(v0[0], v0[1]); w.y = cvt_pk_bf16(v0[2], v0[3]); w.z = cvt_pk_bf16(v1[0], v1[1]); w.w = cvt_pk_bf16(v1[2], v1[3]);
                    *(u32x4*)(rowp + bj * HALF) = w; } }
    }
};
struct EpiResF32 {
    static constexpr bool PERM = true, AFTER_DRAIN = false, PRE = false;
    const float* res; float* out; int ldc;
    __device__ __forceinline__ void operator()(const f32x4 (&acc)[2][2][4][2], const Unit& u, int wr, int wc, int fr, int fq) const {
        const int row0 = u.pm * BM + wr * 64 + fr, col0 = u.pn * BM + wc * 32 + 8 * fq;
#pragma unroll
        for (int ai = 0; ai < 2; ++ai)
#pragma unroll
            for (int m = 0; m < 4; ++m) { const size_t off = (size_t)(row0 + ai * HALF + m * 16) * ldc + col0;
                f32x4 r[2][2];
#pragma unroll
                for (int bj = 0; bj < 2; ++bj) { r[bj][0] = *(const f32x4*)(res + off + bj * HALF); r[bj][1] = *(const f32x4*)(res + off + bj * HALF + 4); }
#pragma unroll
                for (int bj = 0; bj < 2; ++bj) { *(f32x4*)(out + off + bj * HALF) = r[bj][0] + acc[ai][bj][m][0]; *(f32x4*)(out + off + bj * HALF + 4) = r[bj][1] + acc[ai][bj][m][1]; }
                if (m & 1) asm volatile("" ::: "memory"); }
    }
};
struct EpiSwiGLU {
    static constexpr bool PERM = true, AFTER_DRAIN = false, PRE = false;
    bf16_t* O; int ldc; const PG8_LAS float* rl;
    __device__ __forceinline__ void operator()(const f32x4 (&acc)[2][2][4][2], const Unit& u, int wr, int wc, int fr, int fq) const {
        const int row0 = u.pm * BM + wr * 64 + fr, col0 = u.pn * HALF + wc * 32 + 8 * fq;
        const PG8_LAS float* rp = rl + ((u.pm >> 3) & 3) * 256 + wr * 64 + fr;
        float rsv[8];
#pragma unroll
        for (int ai = 0; ai < 2; ++ai)
#pragma unroll
            for (int m = 0; m < 4; ++m) rsv[4 * ai + m] = rp[ai * HALF + m * 16];
#pragma unroll
        for (int ai = 0; ai < 2; ++ai)
#pragma unroll
            for (int m = 0; m < 4; ++m) { bf16_t* rowp = O + (size_t)(row0 + ai * HALF + m * 16) * ldc + col0;
                const float rs = rsv[4 * ai + m], nk = -1.4426950408889634f * rs, rs2 = rs * rs;
                float h[8];
#pragma unroll
                for (int n = 0; n < 2; ++n)
#pragma unroll
                    for (int e = 0; e < 4; ++e) { const float ag = acc[ai][0][m][n][e], au = acc[ai][1][m][n][e];
                        const float r = __builtin_amdgcn_rcpf(1.f + __builtin_amdgcn_exp2f(ag * nk)); h[4 * n + e] = (ag * au) * (rs2 * r); }
                u32x4 w; w.x = cvt_pk_bf16(h[0], h[1]); w.y = cvt_pk_bf16(h[2], h[3]); w.z = cvt_pk_bf16(h[4], h[5]); w.w = cvt_pk_bf16(h[6], h[7]);
                *(u32x4*)rowp = w; }
    }
};
struct EpiResNorm {
    static constexpr bool PERM = true, AFTER_DRAIN = false, PRE = false;
    const float* res; float* out; int ldc; const float* gain; bf16_t* xg; float* part;
    __device__ __forceinline__ void operator()(const f32x4 (&acc)[2][2][4][2], const Unit& u, int wr, int wc, int fr, int fq) const {
        typedef __attribute__((address_space(1))) f32x4 gf4; typedef __attribute__((address_space(1))) u32x4 gu4;
        const int row0 = u.pm * BM + wr * 64 + fr, col0 = u.pn * BM + wc * 32 + 8 * fq;
        f32x4 gv[2][2];
#pragma unroll
        for (int bj = 0; bj < 2; ++bj) { gv[bj][0] = *(const gf4*)(gain + col0 + bj * HALF); gv[bj][1] = *(const gf4*)(gain + col0 + bj * HALF + 4); }
#pragma unroll
        for (int ai = 0; ai < 2; ++ai)
#pragma unroll
            for (int m = 0; m < 4; ++m) { const int row = row0 + ai * HALF + m * 16; const size_t off = (size_t)row * ldc + col0;
                f32x4 r[2][2];
#pragma unroll
                for (int bj = 0; bj < 2; ++bj) { r[bj][0] = *(const gf4*)(res + off + bj * HALF); r[bj][1] = *(const gf4*)(res + off + bj * HALF + 4); }
                float ss = 0.f;
#pragma unroll
                for (int bj = 0; bj < 2; ++bj) { const f32x4 x0 = r[bj][0] + acc[ai][bj][m][0], x1 = r[bj][1] + acc[ai][bj][m][1];
                    *(gf4*)(out + off + bj * HALF) = x0; *(gf4*)(out + off + bj * HALF + 4) = x1;
                    ss += (x0[0] * x0[0] + x0[1] * x0[1]) + (x0[2] * x0[2] + x0[3] * x0[3]) + (x1[0] * x1[0] + x1[1] * x1[1]) + (x1[2] * x1[2] + x1[3] * x1[3]);
                    const f32x4 y0 = x0 * gv[bj][0], y1 = x1 * gv[bj][1];
                    u32x4 w; w.x = cvt_pk_bf16(y0[0], y0[1]); w.y = cvt_pk_bf16(y0[2], y0[3]); w.z = cvt_pk_bf16(y1[0], y1[1]); w.w = cvt_pk_bf16(y1[2], y1[3]);
                    *(gu4*)(xg + off + bj * HALF) = w; }
                ss += __shfl_xor(ss, 16); ss += __shfl_xor(ss, 32);
                if (fq == 0) *(__attribute__((address_space(1))) float*)(part + (size_t)row * 16 + 4 * u.pn + wc) = ss;
                if (m & 1) asm volatile("" ::: "memory"); }
    }
};
struct EpiResBf16 {
    static constexpr bool PERM = true, AFTER_DRAIN = false, PRE = false;
    const float* res; bf16_t* out; int ldc;
    __device__ __forceinline__ void operator()(const f32x4 (&acc)[2][2][4][2], const Unit& u, int wr, int wc, int fr, int fq) const {
        typedef __attribute__((address_space(1))) f32x4 gf4; typedef __attribute__((address_space(1))) u32x4 gu4;
        const int row0 = u.pm * BM + wr * 64 + fr, col0 = u.pn * BM + wc * 32 + 8 * fq;
#pragma unroll
        for (int ai = 0; ai < 2; ++ai)
#pragma unroll
            for (int m = 0; m < 4; ++m) { const size_t off = (size_t)(row0 + ai * HALF + m * 16) * ldc + col0;
                f32x4 r[2][2];
#pragma unroll
                for (int bj = 0; bj < 2; ++bj) { r[bj][0] = *(const gf4*)(res + off + bj * HALF); r[bj][1] = *(const gf4*)(res + off + bj * HALF + 4); }
#pragma unroll
                for (int bj = 0; bj < 2; ++bj) { const f32x4 x0 = r[bj][0] + acc[ai][bj][m][0], x1 = r[bj][1] + acc[ai][bj][m][1];
                    u32x4 w; w.x = cvt_pk_bf16(x0[0], x0[1]); w.y = cvt_pk_bf16(x0[2], x0[3]); w.z = cvt_pk_bf16(x1[0], x1[1]); w.w = cvt_pk_bf16(x1[2], x1[3]);
                    *(gu4*)(out + off + bj * HALF) = w; }
                if (m & 1) asm volatile("" ::: "memory"); }
    }
};
struct EpiResNormB {
    static constexpr bool PERM = true, AFTER_DRAIN = false, PRE = false;
    const void* res; int res_bf16; bf16_t* xr; int ldc; float* part;
    __device__ __forceinline__ void operator()(const f32x4 (&acc)[2][2][4][2], const Unit& u, int wr, int wc, int fr, int fq) const {
        typedef __attribute__((address_space(1))) f32x4 gf4; typedef __attribute__((address_space(1))) u32x4 gu4;
        const int row0 = u.pm * BM + wr * 64 + fr, col0 = u.pn * BM + wc * 32 + 8 * fq;
        u32x4 raw[16];
        if (res_bf16) {
#pragma unroll
            for (int ai = 0; ai < 2; ++ai)
#pragma unroll
                for (int m = 0; m < 4; ++m) { const unsigned off = (unsigned)((row0 + ai * HALF + m * 16) * ldc + col0);
#pragma unroll
                    for (int bj = 0; bj < 2; ++bj) raw[2 * (4 * ai + m) + bj] = *(const gu4*)((const bf16_t*)res + off + bj * HALF); }
        }
#pragma unroll
        for (int ai = 0; ai < 2; ++ai) {
#pragma unroll
            for (int mh = 0; mh < 2; ++mh) {
            if (!res_bf16 && mh == 0) {
#pragma unroll
                for (int m4 = 0; m4 < 4; ++m4) { const unsigned off = (unsigned)((row0 + ai * HALF + m4 * 16) * ldc + col0);
#pragma unroll
                    for (int bj = 0; bj < 2; ++bj) { raw[4 * m4 + 2 * bj] = *(const gu4*)((const float*)res + off + bj * HALF); raw[4 * m4 + 2 * bj + 1] = *(const gu4*)((const float*)res + off + bj * HALF + 4); } }
            }
#pragma unroll
            for (int mm = 0; mm < 2; ++mm) { const int m = 2 * mh + mm; const int row = row0 + ai * HALF + m * 16; const unsigned off = (unsigned)(row * ldc + col0);
                f32x4 r[2][2];
#pragma unroll
                for (int bj = 0; bj < 2; ++bj) {
                    if (res_bf16) { const u32x4 w = raw[2 * (4 * ai + m) + bj];
                        r[bj][0] = (f32x4){__uint_as_float(w.x << 16), __uint_as_float(w.x & 0xffff0000u), __uint_as_float(w.y << 16), __uint_as_float(w.y & 0xffff0000u)};
                        r[bj][1] = (f32x4){__uint_as_float(w.z << 16), __uint_as_float(w.z & 0xffff0000u), __uint_as_float(w.w << 16), __uint_as_float(w.w & 0xffff0000u)}; }
                    else { r[bj][0] = __builtin_bit_cast(f32x4, raw[4 * m + 2 * bj]); r[bj][1] = __builtin_bit_cast(f32x4, raw[4 * m + 2 * bj + 1]); } }
                float ss = 0.f;
#pragma unroll
                for (int bj = 0; bj < 2; ++bj) { const f32x4 x0 = r[bj][0] + acc[ai][bj][m][0], x1 = r[bj][1] + acc[ai][bj][m][1];
                    u32x4 w; w.x = cvt_pk_bf16(x0[0], x0[1]); w.y = cvt_pk_bf16(x0[2], x0[3]); w.z = cvt_pk_bf16(x1[0], x1[1]); w.w = cvt_pk_bf16(x1[2], x1[3]);
                    *(gu4*)(xr + off + bj * HALF) = w;
                    if (part) ss += (x0[0] * x0[0] + x0[1] * x0[1]) + (x0[2] * x0[2] + x0[3] * x0[3]) + (x1[0] * x1[0] + x1[1] * x1[1]) + (x1[2] * x1[2] + x1[3] * x1[3]); }
                if (part) { ss += __shfl_xor(ss, 16); ss += __shfl_xor(ss, 32);
                    if (fq == 0) *(__attribute__((address_space(1))) float*)(part + (size_t)row * 16 + 4 * u.pn + wc) = ss; } }
            asm volatile("" ::: "memory");
            }
            asm volatile("" ::: "memory");
        }
    }
};
struct EpiMemKV {
    static constexpr bool PERM = true, AFTER_DRAIN = false, PRE = false;
    bf16_t* O; int ldc; int rows_per;
    __device__ __forceinline__ void operator()(const f32x4 (&acc)[2][2][4][2], const Unit& u, int wr, int wc, int fr, int fq) const {
        const int lr = (u.pm * BM) / rows_per, lc = (u.pn * BM) / ldc;
        if (lr != lc) return;
        const int row0 = u.pm * BM - lr * rows_per + wr * 64 + fr, col0 = u.pn * BM - lc * ldc + wc * 32 + 8 * fq;
        bf16_t* base = O + (size_t)lr * rows_per * ldc;
#pragma unroll
        for (int ai = 0; ai < 2; ++ai)
#pragma unroll
            for (int m = 0; m < 4; ++m) { bf16_t* rowp = base + (size_t)(row0 + ai * HALF + m * 16) * ldc + col0;
#pragma unroll
                for (int bj = 0; bj < 2; ++bj) { const f32x4 v0 = acc[ai][bj][m][0], v1 = acc[ai][bj][m][1];
                    u32x4 w; w.x = cvt_pk_bf16(v0[0], v0[1]); w.y = cvt_pk_bf16(v0[2], v0[3]); w.z = cvt_pk_bf16(v1[0], v1[1]); w.w = cvt_pk_bf16(v1[2], v1[3]);
                    *(__attribute__((address_space(1))) u32x4*)(rowp + bj * HALF) = w; } }
    }
};
template <class Epi, class Sched, bool ALIGN_EPI = false, bool SP2 = false>
__device__ __forceinline__ void gemm_phase(PG8_LAS unsigned char* lds, const Gemm g, const Sched& S, const Epi& E) {
    int tid_l = threadIdx.x; asm volatile("s_nop 1" : "+v"(tid_l));
    const int tid = tid_l, wid = __builtin_amdgcn_readfirstlane(tid >> 6), lane = tid & 63, wr = wid >> 2, wc = wid & 3, fr = lane & 15, fq = lane >> 4;
    const int K = g.K, nt = K / BK;
    unsigned voffA[2], voffB[2];
#pragma unroll
    for (int i = 0; i < 2; ++i) { int R, C; stage_rc(tid * 16 + i * 8192, R, C); const int Rb = Epi::PERM ? ((R & ~31) + perm32(R & 31)) : R;
        voffA[i] = (unsigned)(R * K + C) * 2u; voffB[i] = (unsigned)(Rb * K + C) * 2u; }
    const size_t kstep = (size_t)(BK * 2);
    const size_t hstep = (size_t)HALF * K * 2;
    const size_t tstep = 2 * hstep;
    const unsigned ldsw = (unsigned)wid * 1024u;
    const int aoff = lds_byte(wr * 64 + fr, fq * 8), boff = lds_byte(wc * 32 + fr, fq * 8);
#define PG8_SA(b, h) (((b) * 2 + (h)) * HTB)
#define PG8_SB(b, h) ((4 + (b) * 2 + (h)) * HTB)
#define PG8_STAGE(bufoff, gbase, voff) do { _Pragma("unroll") for (int _i = 0; _i < 2; ++_i) \
        __builtin_amdgcn_global_load_lds((const unsigned*)((const char*)(gbase) + (voff)[_i]), (PG8_LAS unsigned*)(lds + (bufoff) + ldsw + _i * 8192), 16, 0, 0); } while (0)
#define PG8_LDA(dst, b, h) do { _Pragma("unroll") for (int m = 0; m < 4; ++m) _Pragma("unroll") for (int k = 0; k < 2; ++k) dst[m][k] = *(const PG8_LAS bf16x8*)(lds + PG8_SA(b, h) + aoff + m * 2048 + k * 1024); } while (0)
#define PG8_LDB(dst, b, h) do { _Pragma("unroll") for (int n = 0; n < 2; ++n) _Pragma("unroll") for (int k = 0; k < 2; ++k) dst[n][k] = *(const PG8_LAS bf16x8*)(lds + PG8_SB(b, h) + boff + n * 2048 + k * 1024); } while (0)
#define PG8_MMA(ai, bj, At, Bt) do { __builtin_amdgcn_s_setprio(1); _Pragma("unroll") for (int m = 0; m < 4; ++m) _Pragma("unroll") for (int n = 0; n < 2; ++n) _Pragma("unroll") for (int k = 0; k < 2; ++k) \
        acc[ai][bj][m][n] = __builtin_amdgcn_mfma_f32_16x16x32_bf16(Bt[n][k], At[m][k], acc[ai][bj][m][n], 0, 0, 0); __builtin_amdgcn_s_setprio(0); } while (0)
#define PG8_WAIT_V(n) asm volatile("s_waitcnt vmcnt(" #n ")" ::: "memory")
#define PG8_WAIT_L(n) asm volatile("s_waitcnt lgkmcnt(" #n ")" ::: "memory")
#define PG8_BAR __builtin_amdgcn_s_barrier()
#define PG8_SCHED __builtin_amdgcn_sched_barrier(0)
    Unit cur, nxt; int ui = 0;
    if (!S.next(0, cur)) return;
    f32x4 acc[2][2][4][2];
#pragma unroll
    for (int a = 0; a < 2; ++a)
#pragma unroll
        for (int b = 0; b < 2; ++b)
#pragma unroll
            for (int m = 0; m < 4; ++m)
#pragma unroll
                for (int n = 0; n < 2; ++n) acc[a][b][m][n] = (f32x4){0.f, 0.f, 0.f, 0.f};
    bf16x8 At[4][2], B0[2][2], B1[2][2];
    const char* cA = (const char*)g.A + (size_t)cur.pm * tstep; const char* cB = (const char*)g.Bt + (size_t)cur.pn * tstep;
    S.a_ready(cur);
    if constexpr (SP2) {
        PG8_STAGE(PG8_SB(0, 0), cB, voffB); PG8_STAGE(PG8_SB(0, 1), cB + hstep, voffB); PG8_STAGE(PG8_SA(0, 0), cA, voffA); PG8_STAGE(PG8_SA(0, 1), cA + hstep, voffA);
        if (wr == 1) PG8_BAR;
        PG8_WAIT_V(2); PG8_BAR;
        PG8_STAGE(PG8_SB(1, 0), cB + kstep, voffB); PG8_STAGE(PG8_SA(1, 0), cA + kstep, voffA); PG8_STAGE(PG8_SB(1, 1), cB + hstep + kstep, voffB);
        PG8_WAIT_V(6); PG8_BAR;
    } else {
        PG8_STAGE(PG8_SB(0, 0), cB, voffB); PG8_STAGE(PG8_SA(0, 0), cA, voffA); PG8_STAGE(PG8_SB(0, 1), cB + hstep, voffB); PG8_STAGE(PG8_SA(0, 1), cA + hstep, voffA);
        if (wr == 1) PG8_BAR;
        PG8_WAIT_V(4); PG8_BAR;
        PG8_STAGE(PG8_SB(1, 0), cB + kstep, voffB); PG8_STAGE(PG8_SA(1, 0), cA + kstep, voffA); PG8_STAGE(PG8_SB(1, 1), cB + hstep + kstep, voffB);
        PG8_WAIT_V(6); PG8_BAR;
    }
    for (;;) {
        const bool has_next = S.next(ui + 1, nxt);
        float rsv[8]; if constexpr (Epi::PRE) E.pre(cur, wr, fr, rsv);
        const char* nA = has_next ? (const char*)g.A + (size_t)nxt.pm * tstep : cA; const char* nB = has_next ? (const char*)g.Bt + (size_t)nxt.pn * tstep : cB;
        for (int t = 0; t < nt; t += 2) {
            const bool last = (t == nt - 2);
            const char* a1 = cA + (size_t)(t + 1) * kstep;
            const char* a2 = last ? nA : cA + (size_t)(t + 2) * kstep; const char* b2 = last ? nB : cB + (size_t)(t + 2) * kstep;
            const char* a3 = a2 + kstep; const char* b3 = b2 + kstep;
            if (last && has_next) S.a_ready(nxt);
            if constexpr (SP2) {
            PG8_LDB(B0, 0, 0); PG8_LDB(B1, 0, 1); PG8_SCHED; PG8_LDA(At, 0, 0); PG8_STAGE(PG8_SA(1, 1), a1 + hstep, voffA);
            PG8_WAIT_V(8); PG8_WAIT_L(0); PG8_BAR; PG8_MMA(0, 0, At, B0); PG8_MMA(0, 1, At, B1); PG8_BAR; PG8_SCHED;
            PG8_LDA(At, 0, 1); PG8_STAGE(PG8_SB(0, 0), b2, voffB); PG8_STAGE(PG8_SB(0, 1), b2 + hstep, voffB); PG8_STAGE(PG8_SA(0, 0), a2, voffA);
            PG8_WAIT_V(8); PG8_WAIT_L(0); PG8_BAR; PG8_MMA(1, 0, At, B0); PG8_MMA(1, 1, At, B1); PG8_BAR; PG8_SCHED;
            PG8_LDB(B0, 1, 0); PG8_LDB(B1, 1, 1); PG8_SCHED; PG8_LDA(At, 1, 0); PG8_STAGE(PG8_SA(0, 1), a2 + hstep, voffA);
            PG8_WAIT_V(8); PG8_WAIT_L(0); PG8_BAR; PG8_MMA(0, 0, At, B0); PG8_MMA(0, 1, At, B1); PG8_BAR; PG8_SCHED;
            PG8_LDA(At, 1, 1); PG8_STAGE(PG8_SB(1, 0), b3, voffB); PG8_STAGE(PG8_SB(1, 1), b3 + hstep, voffB); PG8_STAGE(PG8_SA(1, 0), a3, voffA);
            PG8_WAIT_V(8); PG8_WAIT_L(0); PG8_BAR; PG8_MMA(1, 0, At, B0); PG8_MMA(1, 1, At, B1); PG8_BAR; PG8_SCHED;
            } else {
            PG8_LDB(B0, 0, 0); PG8_SCHED; PG8_LDA(At, 0, 0); PG8_STAGE(PG8_SA(1, 1), a1 + hstep, voffA);
            PG8_WAIT_L(8); PG8_BAR; PG8_WAIT_L(0); PG8_MMA(0, 0, At, B0); PG8_BAR; PG8_SCHED;
            PG8_LDB(B1, 0, 1); PG8_STAGE(PG8_SB(0, 0), b2, voffB);
            PG8_BAR; PG8_WAIT_L(0); PG8_MMA(0, 1, At, B1); PG8_BAR;
            PG8_LDA(At, 0, 1); PG8_STAGE(PG8_SA(0, 0), a2, voffA);
            PG8_BAR; PG8_WAIT_L(0); PG8_MMA(1, 0, At, B0); PG8_BAR; PG8_SCHED;
            PG8_STAGE(PG8_SB(0, 1), b2 + hstep, voffB);
            PG8_WAIT_V(6); PG8_BAR; PG8_MMA(1, 1, At, B1); PG8_BAR;
            PG8_LDB(B0, 1, 0); PG8_SCHED; PG8_LDA(At, 1, 0); PG8_STAGE(PG8_SA(0, 1), a2 + hstep, voffA);
            PG8_WAIT_L(8); PG8_BAR; PG8_WAIT_L(0); PG8_MMA(0, 0, At, B0); PG8_BAR; PG8_SCHED;
            PG8_LDB(B1, 1, 1); PG8_STAGE(PG8_SB(1, 0), b3, voffB);
            PG8_BAR; PG8_WAIT_L(0); PG8_MMA(0, 1, At, B1); PG8_BAR;
            PG8_LDA(At, 1, 1); PG8_STAGE(PG8_SA(1, 0), a3, voffA);
            PG8_BAR; PG8_WAIT_L(0); PG8_MMA(1, 0, At, B0); PG8_BAR; PG8_SCHED;
            PG8_STAGE(PG8_SB(1, 1), b3 + hstep, voffB);
            PG8_WAIT_V(6); PG8_BAR; PG8_MMA(1, 1, At, B1); PG8_BAR;
            }
        }
        if constexpr (ALIGN_EPI) { if (wr == 0) PG8_BAR; }
        if constexpr (!Epi::AFTER_DRAIN) { if constexpr (Epi::PRE) E(acc, cur, wr, wc, fr, fq, rsv); else E(acc, cur, wr, wc, fr, fq); S.done(cur); }
        if (!has_next) break;
#pragma unroll
        for (int a = 0; a < 2; ++a)
#pragma unroll
            for (int b = 0; b < 2; ++b)
#pragma unroll
                for (int m = 0; m < 4; ++m)
#pragma unroll
                    for (int n = 0; n < 2; ++n) acc[a][b][m][n] = (f32x4){0.f, 0.f, 0.f, 0.f};
        cur = nxt; cA = nA; cB = nB; ++ui;
        if constexpr (ALIGN_EPI) { if (wr == 1) PG8_BAR; }
    }
    PG8_WAIT_V(0);
    if constexpr (!ALIGN_EPI) { if (wr == 0) PG8_BAR; }
    PG8_BAR;
    if constexpr (Epi::AFTER_DRAIN) { E.fused(acc, cur, wr, wc, fr, fq, lds, wid, lane); S.done(cur); }
#undef PG8_SA
#undef PG8_SB
#undef PG8_STAGE
#undef PG8_LDA
#undef PG8_LDB
#undef PG8_MMA
#undef PG8_WAIT_V
#undef PG8_WAIT_L
#undef PG8_BAR
#undef PG8_SCHED
}
}
constexpr int NWAVES = 8;
constexpr int BATCH = 32, SEQ = 2048, DM = 1024, MTOK = BATCH * SEQ, NMEM = 256, DFF = 2816;
constexpr int N0 = 1752, N0P = 1792, N1 = 1828, N1P = 2048;
constexpr int C0_Q = 0, C0_CKV = 768, C0_KR = 896, C0_QI = 912, C0_KI = 1424, C0_WI = 1488, C0_QM = 1496;
constexpr int C1_Q = 0, C1_KC = 768, C1_VC = 896, C1_KS = 1024, C1_VS = 1152, C1_KW = 1280, C1_VW = 1408, C1_G = 1536, C1_QM = 1572;
constexpr float RMS_EPS = 1e-6f;
constexpr float QSCALE = 0.125f * 1.4426950408889634f;
constexpr size_t MiB = 1u << 20;
constexpr size_t WS_CTL = 0, CTL_ZERO_BYTES = 64 * 1024;
constexpr size_t WS_RSTD = 512 * 1024;
constexpr size_t WS_ROPE = 1 * MiB;
constexpr size_t WS_CMPB = 1 * MiB + 256 * 1024;
constexpr size_t WS_WIN0 = 2 * MiB, WS_WIN1 = 6 * MiB, WS_WMKV = 10 * MiB, WS_WO = 12 * MiB, WS_WFI = 16 * MiB, WS_WFD = 38 * MiB, WS_WC1 = 49 * MiB,
                 WS_WC2 = 50 * MiB, WS_WUKV = 50 * MiB + 64 * 1024;
constexpr size_t WS_MEMN = 52 * MiB, WS_MEMKV = 84 * MiB, WS_K0 = 100 * MiB, WS_V0 = 108 * MiB, WS_KI = 116 * MiB, WS_WI = 124 * MiB, WS_BITM = 126 * MiB,
                 WS_KC = 142 * MiB, WS_VC = 158 * MiB, WS_KCMP = 174 * MiB, WS_VCMP = 175 * MiB, WS_SELM = 176 * MiB, WS_GATES = 177 * MiB, WS_KS = 187 * MiB, WS_KW = 203 * MiB, WS_PART = 219 * MiB;
constexpr size_t WS_H = 224 * MiB, WS_AO = 352 * MiB, WS_COLS = 480 * MiB, WS_QA = 736 * MiB, WS_QB = 832 * MiB, WS_QM = 928 * MiB, WS_END = 960 * MiB;
constexpr size_t WS_OC = WS_H;
constexpr size_t WS_HID = WS_COLS;
static_assert(WS_HID + (size_t)MTOK * DFF * 2 <= WS_QB, "hid overlay");
constexpr int CW_BAR = 4096;
constexpr int LDS_BYTES = 147456;
constexpr int MISC_OFF = 135168;
#define GAS __attribute__((address_space(1)))
#define LAS __attribute__((address_space(3)))
typedef unsigned short bf16;
typedef unsigned u32x4 __attribute__((ext_vector_type(4)));
typedef unsigned u32x2 __attribute__((ext_vector_type(2)));
typedef float f32x4 __attribute__((ext_vector_type(4)));
typedef float f32x16 __attribute__((ext_vector_type(16)));
typedef short bf16x8 __attribute__((ext_vector_type(8)));
typedef short s16x4 __attribute__((ext_vector_type(4)));
#define LDS_WAIT() asm volatile("s_waitcnt lgkmcnt(0)" ::: "memory")
#define LDS_BAR() asm volatile("s_waitcnt lgkmcnt(0)\n\ts_barrier" ::: "memory")
typedef float f32x2_t __attribute__((ext_vector_type(2))); typedef __bf16 bf16x2_t __attribute__((ext_vector_type(2)));
__device__ __forceinline__ unsigned pk2(float lo, float hi) { f32x2_t v = {lo, hi}; bf16x2_t b = __builtin_convertvector(v, bf16x2_t); return __builtin_bit_cast(unsigned, b); }
__device__ __forceinline__ float bflo(unsigned w) { return __uint_as_float(w << 16); }
__device__ __forceinline__ float bfhi(unsigned w) { return __uint_as_float(w & 0xffff0000u); }
__device__ __forceinline__ float wave_sum(float v) {
#pragma unroll
    for (int o = 1; o < 64; o <<= 1) v += __shfl_xor(v, o);
    return v;
}
__device__ __forceinline__ float xhalf_max(float m) { auto rr = __builtin_amdgcn_permlane32_swap(__float_as_uint(m), __float_as_uint(m), false, false); return fmaxf(__uint_as_float(rr[0]), __uint_as_float(rr[1])); }
__device__ __forceinline__ float xhalf_sum(float m) { auto rr = __builtin_amdgcn_permlane32_swap(__float_as_uint(m), __float_as_uint(m), false, false); return __uint_as_float(rr[0]) + __uint_as_float(rr[1]); }
template <class V, class T> __device__ __forceinline__ V ldg(const T* p) { return *(const GAS V*)p; }
template <class V, class T> __device__ __forceinline__ void stg(T* p, V v) { *(GAS V*)p = v; }
#define XB_TMO      128
#define XB_XCNT(j)  (256  + 64 * (j))
#define XB_XSUB(j)  (1280 + 64 * (j))
#define XB_XGEN(j)  (2304 + 64 * (j))
#define XB_TOP      3328
#define XB_TOPGEN   3392
#define XCD_BAR_WORDS 3456
#define XB_SPIN_CAP (1u << 18)

__device__ __forceinline__ unsigned xb_ld(unsigned* p)              { return __hip_atomic_load(p, __ATOMIC_RELAXED, __HIP_MEMORY_SCOPE_AGENT); }
__device__ __forceinline__ unsigned xb_add(unsigned* p, unsigned v) { return __hip_atomic_fetch_add(p, v, __ATOMIC_RELAXED, __HIP_MEMORY_SCOPE_AGENT); }
__device__ __forceinline__ unsigned xb_xcc_id() { return (unsigned)__builtin_amdgcn_s_getreg((3 << 11) | 20) & 0xFu; }
#define XB_SPIN(cond, bar) do { unsigned _sp = 0; while (cond) { __builtin_amdgcn_s_sleep(1); \
    if ((++_sp & 255u) == 0u) { if (xb_ld(&(bar)[XB_TMO])) break; if (_sp > XB_SPIN_CAP) { atomicAdd(&(bar)[XB_TMO], 1u); break; } } } } while (0)

struct XcdBarrier {
    unsigned* bar; unsigned x;
    volatile LAS unsigned* st;
};

__device__ __forceinline__ XcdBarrier xcd_barrier_post(unsigned* bar, volatile LAS unsigned* st) {
    XcdBarrier b; b.bar = bar; b.x = xb_xcc_id(); b.st = st;
    if (threadIdx.x == 0) (void)xb_add(&bar[XB_XCNT(b.x)], 1u);
    return b;
}
__device__ __forceinline__ void xcd_barrier_complete(unsigned* bar, unsigned x, unsigned& nloc, unsigned& nx) {
    const unsigned G = gridDim.x * gridDim.y * gridDim.z;
    unsigned sum, cnt, mine, sp = 0u;
    for (;;) {
        sum = 0u; cnt = 0u; mine = 0u;
#pragma unroll
        for (unsigned j = 0; j < 16; ++j) { const unsigned c = xb_ld(&bar[XB_XCNT(j)]); sum += c; cnt += (c > 0u) ? 1u : 0u; mine = (j == x) ? c : mine; }
        if (sum == G) break;
        __builtin_amdgcn_s_sleep(1);
        if ((++sp & 255u) == 0u) { if (xb_ld(&bar[XB_TMO])) break; if (sp > XB_SPIN_CAP) { atomicAdd(&bar[XB_TMO], 1u); break; } }
    }
    nloc = mine > 0u ? mine : 1u; nx = cnt > 0u ? cnt : 1u;
}

__device__ __forceinline__ void xcd_barrier(const XcdBarrier& b) {
    asm volatile("s_waitcnt vmcnt(0)" ::: "memory");
    __syncthreads();
    if (threadIdx.x == 0) {
        unsigned* bar = b.bar;
        __builtin_amdgcn_s_waitcnt(0);
        unsigned nloc = b.st[0], nx = b.st[1];
        if (nloc == 0u) { xcd_barrier_complete(bar, b.x, nloc, nx); b.st[0] = nloc; b.st[1] = nx; }
        const unsigned old = xb_add(&bar[XB_XSUB(b.x)], 1u);
        const unsigned gen = old / nloc;
        if (old + 1u == (gen + 1u) * nloc) {
            __builtin_amdgcn_fence(__ATOMIC_RELEASE, "agent");
            asm volatile("s_waitcnt vmcnt(0)" ::: "memory");
            const unsigned og = xb_add(&bar[XB_TOP], 1u);
            const unsigned tg = og / nx;
            if (og + 1u == (tg + 1u) * nx) xb_add(&bar[XB_TOPGEN], 1u);
            else XB_SPIN(xb_ld(&bar[XB_TOPGEN]) == tg, bar);
            __builtin_amdgcn_fence(__ATOMIC_ACQUIRE, "agent");
            xb_add(&bar[XB_XGEN(b.x)], 1u);
            asm volatile("s_waitcnt vmcnt(0)" ::: "memory");
        } else {
            XB_SPIN(xb_ld(&bar[XB_XGEN(b.x)]) == gen, bar);
            __builtin_amdgcn_fence(__ATOMIC_ACQUIRE, "agent");
            asm volatile("s_waitcnt vmcnt(0)" ::: "memory");
        }
    }
    __syncthreads();
}
struct Ctx { LAS unsigned char* lds; int tid, lane, wave, gw, ngw; };
__device__ __forceinline__ float tr_row_scale(int mode, int n) {
    if (mode == 2) return (n < 768 || (n >= C0_QM && n < C0_QM + 256)) ? QSCALE : ((n >= C0_WI && n < C0_WI + 8) ? 0.044194173824159216f : 1.f);
    if (mode == 3) return (n < 768 || (n >= C1_QM && n < C1_QM + 256)) ? QSCALE : 1.f;
    return 1.f;
}
__device__ __forceinline__ void tr_item(const float* W, int ldw, int nvalid, int src_col0, int k0, bf16* WT, int K, int dst_row0, LAS float* scr, int lane, int mode = 0, const float* kgain = nullptr) {
    const int n4 = (lane & 7) * 4, rr = lane >> 3, c_src = src_col0 + n4; const bool ok = c_src < nvalid;
#pragma unroll
    for (int i = 0; i < 8; ++i) { const int kk = 8 * i + rr; const f32x4 v = ok ? ldg<f32x4>(W + (size_t)(k0 + kk) * ldw + c_src) : (f32x4){0.f, 0.f, 0.f, 0.f};
        scr[kk * 33 + n4] = v.x; scr[kk * 33 + n4 + 1] = v.y; scr[kk * 33 + n4 + 2] = v.z; scr[kk * 33 + n4 + 3] = v.w; }
    LDS_WAIT(); asm volatile("" ::: "memory");
    const int c = lane & 7;
    f32x4 kg0 = {1.f, 1.f, 1.f, 1.f}, kg1 = {1.f, 1.f, 1.f, 1.f};
    if (kgain) { kg0 = ldg<f32x4>(kgain + k0 + 8 * c); kg1 = ldg<f32x4>(kgain + k0 + 8 * c + 4); }
#pragma unroll
    for (int j = 0; j < 4; ++j) { const int n = (lane >> 3) + 8 * j; const LAS float* s = scr + (8 * c) * 33 + n; const float sc = tr_row_scale(mode, dst_row0 + n);
        u32x4 o; o.x = pk2(s[0 * 33] * sc * kg0.x, s[1 * 33] * sc * kg0.y); o.y = pk2(s[2 * 33] * sc * kg0.z, s[3 * 33] * sc * kg0.w); o.z = pk2(s[4 * 33] * sc * kg1.x, s[5 * 33] * sc * kg1.y); o.w = pk2(s[6 * 33] * sc * kg1.z, s[7 * 33] * sc * kg1.w);
        stg<u32x4>(WT + (size_t)(dst_row0 + n) * K + k0 + 8 * c, o); }
    LDS_WAIT(); asm volatile("" ::: "memory");
}
__device__ __forceinline__ bool tr_mat(int& r, const float* W, int K, int ldw, int nvalid, int nblk, bf16* WT, int dst_row0, int mode, LAS float* scr, int lane, const float* kgain = nullptr) {
    const int nit = (K / 64) * nblk;
    if (r >= nit) { r -= nit; return false; }
    const int kb = r / nblk, nb = r % nblk;
    int src_col0 = 32 * nb;
    if (mode == 1) { const int rp = 32 * nb, pn = rp >> 8, hh = (rp >> 7) & 1, j = rp & 127; src_col0 = hh * DFF + 128 * pn + j; }
    tr_item(W, ldw, nvalid, src_col0, 64 * kb, WT, K, dst_row0 + 32 * nb, scr, lane, mode, kgain);
    return true;
}
__device__ __forceinline__ void rmsnorm_rows_bf16(const Ctx& C, const float* X, const float* gain, bf16* out, int nrows) {
    f32x4 g[4];
#pragma unroll
    for (int j = 0; j < 4; ++j) g[j] = ldg<f32x4>((const f32x4*)gain + C.lane + 64 * j);
    for (int m = C.gw; m < nrows; m += C.ngw) {
        const GAS f32x4* xr = (const GAS f32x4*)(X + (size_t)m * DM) + C.lane;
        f32x4 v[4]; float s = 0.f;
#pragma unroll
        for (int j = 0; j < 4; ++j) { v[j] = xr[64 * j]; s += (v[j].x * v[j].x + v[j].y * v[j].y) + (v[j].z * v[j].z + v[j].w * v[j].w); }
        const float rstd = 1.f / sqrtf(wave_sum(s) * (1.f / DM) + RMS_EPS);
        GAS u32x2* o8 = (GAS u32x2*)(out + (size_t)m * DM) + C.lane;
#pragma unroll
        for (int j = 0; j < 4; ++j) { u32x2 w; w.x = pk2(v[j].x * rstd * g[j].x, v[j].y * rstd * g[j].y); w.y = pk2(v[j].z * rstd * g[j].z, v[j].w * rstd * g[j].w); o8[64 * j] = w; }
    }
}
__device__ __forceinline__ void rmsnorm_rows_bf16_x2(const Ctx& C, const float* X, const float* gainA, const float* gainB, bf16* outA, bf16* outB, int nrows) {
    f32x4 ga[4], gb[4];
#pragma unroll
    for (int j = 0; j < 4; ++j) { ga[j] = ldg<f32x4>((const f32x4*)gainA + C.lane + 64 * j); gb[j] = ldg<f32x4>((const f32x4*)gainB + C.lane + 64 * j); }
    for (int m = C.gw; m < nrows; m += C.ngw) {
        const GAS f32x4* xr = (const GAS f32x4*)(X + (size_t)m * DM) + C.lane;
        f32x4 v[4]; float s = 0.f;
#pragma unroll
        for (int j = 0; j < 4; ++j) { v[j] = xr[64 * j]; s += (v[j].x * v[j].x + v[j].y * v[j].y) + (v[j].z * v[j].z + v[j].w * v[j].w); }
        const float rstd = 1.f / sqrtf(wave_sum(s) * (1.f / DM) + RMS_EPS);
        GAS u32x2* oa = (GAS u32x2*)(outA + (size_t)m * DM) + C.lane; GAS u32x2* ob = (GAS u32x2*)(outB + (size_t)m * DM) + C.lane;
#pragma unroll
        for (int j = 0; j < 4; ++j) { u32x2 w; w.x = pk2(v[j].x * rstd * ga[j].x, v[j].y * rstd * ga[j].y); w.y = pk2(v[j].z * rstd * ga[j].z, v[j].w * rstd * ga[j].w); oa[64 * j] = w;
                                      u32x2 z; z.x = pk2(v[j].x * rstd * gb[j].x, v[j].y * rstd * gb[j].y); z.y = pk2(v[j].z * rstd * gb[j].z, v[j].w * rstd * gb[j].w); ob[64 * j] = z; }
    }
}
__device__ __forceinline__ void rmsnorm_rows_f32_inplace(const Ctx& C, float* X, const float* gain, int nrows) {
    f32x4 g[4];
#pragma unroll
    for (int j = 0; j < 4; ++j) g[j] = ldg<f32x4>((const f32x4*)gain + C.lane + 64 * j);
    for (int m = C.gw; m < nrows; m += C.ngw) {
        GAS f32x4* xr = (GAS f32x4*)(X + (size_t)m * DM) + C.lane;
        f32x4 v[4]; float s = 0.f;
#pragma unroll
        for (int j = 0; j < 4; ++j) { v[j] = xr[64 * j]; s += (v[j].x * v[j].x + v[j].y * v[j].y) + (v[j].z * v[j].z + v[j].w * v[j].w); }
        const float rstd = 1.f / sqrtf(wave_sum(s) * (1.f / DM) + RMS_EPS);
#pragma unroll
        for (int j = 0; j < 4; ++j) xr[64 * j] = v[j] * rstd * g[j];
    }
}
__device__ __forceinline__ void final_norm_rows(const Ctx& C, const bf16* X, const float* gain, float* out, int nrows) {
    f32x4 g[4];
#pragma unroll
    for (int j = 0; j < 2; ++j) { g[2 * j] = ldg<f32x4>(gain + 512 * j + 8 * C.lane); g[2 * j + 1] = ldg<f32x4>(gain + 512 * j + 8 * C.lane + 4); }
    for (int m = C.gw; m < nrows; m += C.ngw) {
        const bf16* xr = X + (size_t)m * DM + 8 * C.lane; float v[16]; float s = 0.f;
#pragma unroll
        for (int j = 0; j < 2; ++j) { const u32x4 a = ldg<u32x4>(xr + 512 * j);
            v[8 * j] = bflo(a.x); v[8 * j + 1] = bfhi(a.x); v[8 * j + 2] = bflo(a.y); v[8 * j + 3] = bfhi(a.y); v[8 * j + 4] = bflo(a.z); v[8 * j + 5] = bfhi(a.z); v[8 * j + 6] = bflo(a.w); v[8 * j + 7] = bfhi(a.w); }
#pragma unroll
        for (int e = 0; e < 16; ++e) s += v[e] * v[e];
        const float rstd = 1.f / sqrtf(wave_sum(s) * (1.f / DM) + RMS_EPS);
        float* orow = out + (size_t)m * DM + 8 * C.lane;
#pragma unroll
        for (int j = 0; j < 2; ++j) { stg<f32x4>(orow + 512 * j, (f32x4){v[8 * j] * rstd, v[8 * j + 1] * rstd, v[8 * j + 2] * rstd, v[8 * j + 3] * rstd} * g[2 * j]);
                                      stg<f32x4>(orow + 512 * j + 4, (f32x4){v[8 * j + 4] * rstd, v[8 * j + 5] * rstd, v[8 * j + 6] * rstd, v[8 * j + 7] * rstd} * g[2 * j + 1]); }
    }
}
__device__ __forceinline__ void rstd_rows(const Ctx& C, unsigned char* ws) {
    const float* part = (const float*)(ws + WS_PART); float* rstd = (float*)(ws + WS_RSTD);
    for (int row = C.gw * 64 + C.lane; row < MTOK; row += C.ngw * 64) { const f32x4* p = (const f32x4*)(part + (size_t)row * 16);
        const f32x4 a = ldg<f32x4>(p), b = ldg<f32x4>(p + 1), c = ldg<f32x4>(p + 2), d = ldg<f32x4>(p + 3);
        const float s = ((a.x + a.y) + (a.z + a.w)) + ((b.x + b.y) + (b.z + b.w)) + ((c.x + c.y) + (c.z + c.w)) + ((d.x + d.y) + (d.z + d.w));
        stg<float>(rstd + row, 1.f / sqrtf(s * (1.f / DM) + RMS_EPS)); }
}
struct In {
    const float *x, *mem, *attn_norm, *mem_norm, *ffn_norm, *final_norm, *dsa_w_in, *dsa_ckv_norm, *dsa_w_uk, *dsa_w_uv, *nsa_w_in, *pos_k, *pos_v,
                *ck_w1, *ck_w2, *cv_w1, *cv_w2, *mem_w_kv, *w_o, *ffn_w_in, *ffn_w_down;
};
__device__ __forceinline__ void p0_prologue(const Ctx& C, const In& I, unsigned char* ws) {
    LAS float* scr = (LAS float*)(C.lds + C.wave * 16384);
    bf16* win0 = (bf16*)(ws + WS_WIN0); bf16* win1 = (bf16*)(ws + WS_WIN1); bf16* wmkv = (bf16*)(ws + WS_WMKV); bf16* wo = (bf16*)(ws + WS_WO);
    bf16* wfi = (bf16*)(ws + WS_WFI); bf16* wfd = (bf16*)(ws + WS_WFD); bf16* wc1 = (bf16*)(ws + WS_WC1); bf16* wc2 = (bf16*)(ws + WS_WC2); bf16* wukv = (bf16*)(ws + WS_WUKV);
    constexpr int NIT = 16 * 56 + 16 * 64 + 2 * 16 * 16 + 2 * 16 * 32 + 2 * 16 * 176 + 2 * 44 * 32 + 2 * 32 * 4 + 2 * 2 * 2 + 2 * 4;
    for (int it = C.gw; it < NIT; it += C.ngw) {
        int r = it;
        if (tr_mat(r, I.dsa_w_in, 1024, N0, N0, 56, win0, 0, 2, scr, C.lane)) continue;
        if (tr_mat(r, I.nsa_w_in, 1024, N1, N1, 64, win1, 0, 3, scr, C.lane, I.attn_norm + DM)) continue;
        if (tr_mat(r, I.mem_w_kv, 1024, 512, 512, 16, wmkv, 0, 0, scr, C.lane)) continue;
        if (tr_mat(r, I.mem_w_kv + (size_t)1024 * 512, 1024, 512, 512, 16, wmkv + (size_t)512 * 1024, 0, 0, scr, C.lane)) continue;
        if (tr_mat(r, I.w_o, 1024, 1024, 1024, 32, wo, 0, 0, scr, C.lane)) continue;
        if (tr_mat(r, I.w_o + (size_t)1024 * 1024, 1024, 1024, 1024, 32, wo + (size_t)1024 * 1024, 0, 0, scr, C.lane)) continue;
        if (tr_mat(r, I.ffn_w_in, 1024, 2 * DFF, 2 * DFF, 176, wfi, 0, 1, scr, C.lane, I.ffn_norm)) continue;
        if (tr_mat(r, I.ffn_w_in + (size_t)1024 * 2 * DFF, 1024, 2 * DFF, 2 * DFF, 176, wfi + (size_t)2 * DFF * 1024, 0, 1, scr, C.lane, I.ffn_norm + DM)) continue;
        if (tr_mat(r, I.ffn_w_down, DFF, 1024, 1024, 32, wfd, 0, 0, scr, C.lane)) continue;
        if (tr_mat(r, I.ffn_w_down + (size_t)DFF * 1024, DFF, 1024, 1024, 32, wfd + (size_t)1024 * DFF, 0, 0, scr, C.lane)) continue;
        if (tr_mat(r, I.ck_w1, 2048, 128, 128, 4, wc1, 0, 0, scr, C.lane)) continue;
        if (tr_mat(r, I.cv_w1, 2048, 128, 128, 4, wc1 + (size_t)128 * 2048, 0, 0, scr, C.lane)) continue;
        if (tr_mat(r, I.ck_w2, 128, 64, 64, 2, wc2, 0, 0, scr, C.lane)) continue;
        if (tr_mat(r, I.cv_w2, 128, 64, 64, 2, wc2 + (size_t)64 * 128, 0, 0, scr, C.lane)) continue;
        if (tr_mat(r, I.dsa_w_uk, 128, 48, 48, 2, wukv, 0, 0, scr, C.lane)) continue;
        tr_mat(r, I.dsa_w_uv, 128, 64, 64, 2, wukv, 64, 0, scr, C.lane);
    }
    {   const double inv[8] = {1.0, 0.19392274474868576, 0.03760603093086393, 0.0072926647372171085, 0.0014142135623730952, 0.0002742481756762073, 5.318295896944988e-05, 1.0313385377212458e-05};
        float* ct = (float*)(ws + WS_ROPE); float* st = ct + SEQ * 8;
        for (int idx = C.gw * 64 + C.lane; idx < SEQ * 8; idx += C.ngw * 64) { const int pos = idx >> 3, i = idx & 7;
            double iv = inv[0];
#pragma unroll
            for (int q = 1; q < 8; ++q) iv = (i == q) ? inv[q] : iv;
            const double a = (double)pos * iv; stg<float>(ct + idx, (float)cos(a)); stg<float>(st + idx, (float)sin(a)); }
    }
    {   float* pb = (float*)(ws + WS_CMPB);
        for (int o = C.gw; o < 128; o += C.ngw) { const int kc = o & 31, nb = (o >> 5) & 1, kv = o >> 6; const float* pos = (kv ? I.pos_v : I.pos_k) + 64 * kc; const float* w1 = (kv ? I.cv_w1 : I.ck_w1) + (size_t)(64 * kc) * 128 + 64 * nb + C.lane;
            float s = 0.f;
#pragma unroll 32
            for (int kk = 0; kk < 64; ++kk) s += ldg<float>(pos + kk) * ldg<float>(w1 + (size_t)kk * 128);
            stg<float>(pb + o * 64 + C.lane, s); }
    }
    rmsnorm_rows_bf16(C, I.x, I.attn_norm, (bf16*)(ws + WS_H), MTOK);
    rmsnorm_rows_bf16_x2(C, I.mem, I.mem_norm, I.mem_norm + DM, (bf16*)(ws + WS_MEMN), (bf16*)(ws + WS_MEMN) + (size_t)BATCH * NMEM * DM, BATCH * NMEM);
}
namespace att {
constexpr int KSTR = 128, KBYTES = 64 * KSTR, VBYTES = 64 * 128, BUFB = KBYTES + VBYTES;
constexpr int LDS_NEED = 4 * BUFB;
enum { M_NONE = 0, M_BITS = 1, M_BLOCK = 2, M_WIN = 3 };
struct Src { const bf16* K; const bf16* V; int kpitch, vpitch; };
template <int EM> struct EpiStore {
    bf16* obase; int ooff; const float* gbase; int goff; const bf16* ocbase; int ocoff;
    __device__ __forceinline__ float gate(int i) const { return (EM >= 1) ? ldg<float>(gbase + goff + 3 * i) : 1.f; }
    __device__ __forceinline__ void store8(int i, int dcol, u32x4 w) const {
        const int col = i * 64 + dcol; bf16* orow = obase + ooff;
        if (EM == 2) { const u32x4 s = ldg<u32x4>(orow + col); const u32x4 t = ldg<u32x4>(ocbase + ocoff + col);
            w.x = pk2(bflo(w.x) + bflo(s.x) + bflo(t.x), bfhi(w.x) + bfhi(s.x) + bfhi(t.x)); w.y = pk2(bflo(w.y) + bflo(s.y) + bflo(t.y), bfhi(w.y) + bfhi(s.y) + bfhi(t.y));
            w.z = pk2(bflo(w.z) + bflo(s.z) + bflo(t.z), bfhi(w.z) + bfhi(s.z) + bfhi(t.z)); w.w = pk2(bflo(w.w) + bflo(s.w) + bflo(t.w), bfhi(w.w) + bfhi(s.w) + bfhi(t.w)); }
        stg<u32x4>(orow + col, w);
    }
};
__device__ __forceinline__ s16x4 vtr(const LAS unsigned char* p) { typedef short v4i16_t __attribute__((ext_vector_type(4)));
    return __builtin_bit_cast(s16x4, __builtin_amdgcn_ds_read_tr16_b64_v4i16((LAS v4i16_t*)p)); }
#define ATT_C(r) (8 * ((r) >> 2) + ((r) & 3))
#define ATT_THR 8
#define ATT_THR_BITS 0x41000000
template <int R, int MODE, class Epi>
__device__ __forceinline__ void attn_unit(LAS unsigned char* lds, const Src S, int kt_lo, int kt_hi, const bf16* Qrow, const bf16* Qrot, int tq, int tq0w,
                                          const unsigned* maskrow, unsigned blocksel, const Epi E, int tid, int lane) {
    const int r32 = lane & 31, hi = lane >> 5;
    bf16x8 qf[R][4];
#pragma unroll
    for (int i = 0; i < R; ++i)
#pragma unroll
        for (int st = 0; st < 4; ++st) qf[i][st] = (st == 0 && Qrot) ? ldg<bf16x8>(Qrot + i * 16 + 8 * hi) : ldg<bf16x8>(Qrow + i * 64 + 16 * st + 8 * hi);
    f32x16 o[R][2]; float mref = 0.f, lrun[R]; bool started = false;
    unsigned long long nst = ~0ull;
    f32x16 negv;
#pragma unroll
    for (int r = 0; r < 16; ++r) negv[r] = 0.f;
#pragma unroll
    for (int i = 0; i < R; ++i) { lrun[i] = 0.f;
#pragma unroll
        for (int r = 0; r < 16; ++r) { o[i][0][r] = 0.f; o[i][1][r] = 0.f; } }
    const int wv = __builtin_amdgcn_readfirstlane(tid >> 6);
    const int krow = 8 * wv + (lane >> 3), kch = (lane & 7) ^ ((krow >> 1) & 7);
    const int kgo = krow * S.kpitch + kch * 8, vgo = (16 * (wv & 3) + (lane >> 2)) * S.vpitch + (wv >> 2) * 32 + (lane & 3) * 8;
    const int kdst = wv * 1024, vdst = KBYTES + (wv >> 2) * 4096 + (wv & 3) * 1024;
#define ATT_GLDS(gsrc, ldsdst) do { unsigned keep_; asm volatile("s_mov_b32 %0, m0\n\ts_mov_b32 m0, %2\n\ts_nop 0\n\tglobal_load_lds_dwordx4 %1, off\n\ts_mov_b32 m0, %0" : "=&s"(keep_) : "v"(gsrc), "s"(ldsdst) : "memory"); } while (0)
#define ATT_DMA(t, bufbase) do { const unsigned lb_ = (unsigned)(uintptr_t)(bufbase); \
                                 ATT_GLDS((const GAS bf16*)(S.K + (size_t)(t) * 64 * S.kpitch + kgo), (unsigned)__builtin_amdgcn_readfirstlane(lb_ + kdst)); \
                                 ATT_GLDS((const GAS bf16*)(S.V + (size_t)(t) * 64 * S.vpitch + vgo), (unsigned)__builtin_amdgcn_readfirstlane(lb_ + vdst)); } while (0)
#define ATT_BAR_DMA() asm volatile("s_waitcnt vmcnt(0) lgkmcnt(0)\n\ts_barrier" ::: "memory")
    const int kx = (r32 >> 1) & 7; int koffs[4];
#pragma unroll
    for (int st = 0; st < 4; ++st) koffs[st] = r32 * KSTR + (((2 * st + hi) ^ kx) * 16);
    const int voff = KBYTES + ((lane >> 4) & 1) * 32 + (lane & 3) * 8 + (4 * hi + ((lane & 15) >> 2)) * 64;
    ATT_DMA(kt_lo, lds); ATT_DMA(kt_lo + 1, lds + BUFB);
    u32x4 mw4 = {0u, 0u, 0u, 0u}, mwn4 = {0u, 0u, 0u, 0u};
    if (MODE == M_BITS) mwn4 = ldg<u32x4>(maskrow + 2 * kt_lo);
    for (int kt2 = kt_lo; kt2 < kt_hi; kt2 += 2) {
        LAS unsigned char* buf2 = lds + (((kt2 - kt_lo) >> 1) & 1) * (2 * BUFB);
        ATT_BAR_DMA();
        mw4 = mwn4;
        if (kt2 + 2 < kt_hi) { LAS unsigned char* nb = lds + ((((kt2 - kt_lo) >> 1) + 1) & 1) * (2 * BUFB); ATT_DMA(kt2 + 2, nb); ATT_DMA(kt2 + 3, nb + BUFB);
            if (MODE == M_BITS) mwn4 = ldg<u32x4>(maskrow + 2 * (kt2 + 2)); }
        bf16x8 kf[4]; bool havek = false;
#pragma unroll 1
      for (int h2 = 0; h2 < 2; ++h2) { const int kt = kt2 + h2; LAS unsigned char* buf = buf2 + h2 * BUFB;
        u32x2 mw; mw.x = h2 ? mw4.z : mw4.x; mw.y = h2 ? mw4.w : mw4.y;
        const bool bsel = (MODE == M_BLOCK) ? (((blocksel >> kt) & 1u) != 0u) : true;
        const bool allsel = (MODE == M_BLOCK) ? (__all(bsel) != 0) : true;
        const bool need_c = (MODE == M_BLOCK || MODE == M_WIN) ? (64 * kt + 63 > tq0w) : false;
        const bool need_w = (MODE == M_WIN) ? (64 * kt <= tq0w + 31 - 512) : false;
        bool active = true;
        if (MODE != M_NONE) active = (64 * kt <= tq0w + 31);
        if (MODE == M_WIN) active = active && (64 * kt + 63 > tq0w - 512);
        if (active)
#pragma unroll 1
        for (int sub = 0; sub < 2; ++sub) {
            if (!havek) {
#pragma unroll
                for (int st = 0; st < 4; ++st) kf[st] = *(const LAS bf16x8*)(buf + koffs[st] + sub * 32 * KSTR); }
            bf16x8 vf[2][2];
#pragma unroll
            for (int d0 = 0; d0 < 2; ++d0)
#pragma unroll
                for (int j = 0; j < 2; ++j) { const LAS unsigned char* vp = buf + voff + d0 * 4096 + (32 * sub + 16 * j) * 64;
                    const s16x4 a = vtr(vp), b = vtr(vp + 8 * 64); vf[d0][j] = (bf16x8){a[0], a[1], a[2], a[3], b[0], b[1], b[2], b[3]}; }
            const int dk = tq - (64 * kt + 32 * sub + 4 * hi);
            const unsigned wsh = (sub ? mw.y : mw.x) >> (4 * hi);
            f32x16 sarr[R]; const float negm = -mref;
            __builtin_amdgcn_s_setprio(1);
            const bool plain = (MODE == M_NONE) || (MODE == M_BLOCK && !need_c && allsel) || (MODE == M_WIN && !(need_c || need_w));
            if (plain) {
#pragma unroll
                for (int i = 0; i < R; ++i) sarr[i] = __builtin_amdgcn_mfma_f32_32x32x16_bf16(kf[0], qf[i][0], negv, 0, 0, 0);
            } else {
                f32x16 ci;
                if (MODE == M_BITS) { const unsigned nb = __float_as_uint(negm);
#pragma unroll
                    for (int r = 0; r < 16; ++r) { const unsigned t = (unsigned)__builtin_amdgcn_sbfe((int)wsh, ATT_C(r), 1); ci[r] = __uint_as_float((t & nb) | (~t & 0xFF800000u)); }
                } else if (MODE == M_BLOCK) {
                    if (need_c) {
#pragma unroll
                        for (int r = 0; r < 16; ++r) ci[r] = (bsel && ATT_C(r) <= dk) ? negm : -INFINITY;
                    } else { const float c1 = bsel ? negm : -INFINITY;
#pragma unroll
                        for (int r = 0; r < 16; ++r) ci[r] = c1; }
                } else {
#pragma unroll
                    for (int r = 0; r < 16; ++r) ci[r] = (ATT_C(r) <= dk && ATT_C(r) + 512 > dk) ? negm : -INFINITY;
                }
#pragma unroll
                for (int i = 0; i < R; ++i) sarr[i] = __builtin_amdgcn_mfma_f32_32x32x16_bf16(kf[0], qf[i][0], ci, 0, 0, 0);
            }
#pragma unroll
            for (int st = 1; st < 4; ++st)
#pragma unroll
                for (int i = 0; i < R; ++i) sarr[i] = __builtin_amdgcn_mfma_f32_32x32x16_bf16(kf[st], qf[i][st], sarr[i], 0, 0, 0);
            __builtin_amdgcn_s_setprio(0);
            {   const int nq = 2 * h2 + sub + 1; havek = nq < 4;
                if (havek) { const LAS unsigned char* nbuf = buf2 + (nq >> 1) * BUFB + (nq & 1) * (32 * KSTR);
#pragma unroll
                    for (int st = 0; st < 4; ++st) kf[st] = *(const LAS bf16x8*)(nbuf + koffs[st]); } }
            __builtin_amdgcn_sched_barrier(0);
            int mi;
            {
#define ATT_SI(k) __float_as_int(sarr[(k) >> 4][(k) & 15])
#define ATT_M3(a, b, c) max(max((a), (b)), (c))
                if constexpr (R == 2) {
                    int t[10];
#pragma unroll
                    for (int j = 0; j < 10; ++j) t[j] = ATT_M3(ATT_SI(3 * j), ATT_SI(3 * j + 1), ATT_SI(3 * j + 2));
                    const int u0 = ATT_M3(t[0], t[1], t[2]), u1 = ATT_M3(t[3], t[4], t[5]), u2 = ATT_M3(t[6], t[7], t[8]), u3 = ATT_M3(t[9], ATT_SI(30), ATT_SI(31));
                    mi = max(ATT_M3(u0, u1, u2), u3);
                } else {
                    int t[5];
#pragma unroll
                    for (int j = 0; j < 5; ++j) t[j] = ATT_M3(ATT_SI(3 * j), ATT_SI(3 * j + 1), ATT_SI(3 * j + 2));
                    mi = max(ATT_M3(t[0], t[1], t[2]), ATT_M3(t[3], t[4], ATT_SI(15)));
                }
#undef ATT_SI
#undef ATT_M3
            }
            if ((__builtin_amdgcn_ballot_w64(mi > (int)ATT_THR_BITS) | nst) != 0ull) {
            float mx = -INFINITY;
#pragma unroll
            for (int i = 0; i < R; ++i) {
#pragma unroll
                for (int r = 0; r < 16; r += 4) mx = fmaxf(mx, fmaxf(fmaxf(sarr[i][r], sarr[i][r + 1]), fmaxf(sarr[i][r + 2], sarr[i][r + 3]))); }
            mx = xhalf_max(mx);
            const bool first = !started && mx > -INFINITY, raise = started && mx > (float)ATT_THR;
            if (__any(first || raise)) {
                const float d = (first || raise) ? mx : 0.f, al = __builtin_amdgcn_exp2f(-d); started = started || first; nst = __builtin_amdgcn_ballot_w64(!started); mref += d;
#pragma unroll
                for (int i = 0; i < R; ++i) { lrun[i] *= al;
#pragma unroll
                    for (int r = 0; r < 16; ++r) { sarr[i][r] -= d; o[i][0][r] *= al; o[i][1][r] *= al; } }
                if (MODE != M_BITS) {
#pragma unroll
                    for (int r = 0; r < 16; ++r) negv[r] = -mref; }
            }
            }
#pragma unroll
            for (int i = 0; i < R; ++i) {
                f32x16 s = sarr[i];
                float ls = 0.f;
#pragma unroll
                for (int r = 0; r < 16; ++r) { s[r] = __builtin_amdgcn_exp2f(s[r]); ls += s[r]; }
                lrun[i] += ls;
                u32x4 p0, p1;
                p0.x = pk2(s[0], s[1]); p0.y = pk2(s[2], s[3]); p0.z = pk2(s[4], s[5]); p0.w = pk2(s[6], s[7]);
                p1.x = pk2(s[8], s[9]); p1.y = pk2(s[10], s[11]); p1.z = pk2(s[12], s[13]); p1.w = pk2(s[14], s[15]);
                const bf16x8 pa0 = __builtin_bit_cast(bf16x8, p0), pa1 = __builtin_bit_cast(bf16x8, p1);
#pragma unroll
                for (int d0 = 0; d0 < 2; ++d0) { o[i][d0] = __builtin_amdgcn_mfma_f32_32x32x16_bf16(vf[d0][0], pa0, o[i][d0], 0, 0, 0);
                                                 o[i][d0] = __builtin_amdgcn_mfma_f32_32x32x16_bf16(vf[d0][1], pa1, o[i][d0], 0, 0, 0); }
            }
        }
      }
    }
#pragma unroll
    for (int i = 0; i < R; ++i) { const float lt = xhalf_sum(lrun[i]); const float inv = E.gate(i) / fmaxf(lt, 1e-30f);
#pragma unroll
        for (int d0 = 0; d0 < 2; ++d0)
#pragma unroll
            for (int rp = 0; rp < 2; ++rp) { const int r0 = 8 * rp;
                const unsigned ax = pk2(o[i][d0][r0] * inv, o[i][d0][r0 + 1] * inv), ay = pk2(o[i][d0][r0 + 2] * inv, o[i][d0][r0 + 3] * inv);
                const unsigned bx = pk2(o[i][d0][r0 + 4] * inv, o[i][d0][r0 + 5] * inv), by = pk2(o[i][d0][r0 + 6] * inv, o[i][d0][r0 + 7] * inv);
                const auto sx = __builtin_amdgcn_permlane32_swap(ax, bx, false, false); const auto sy = __builtin_amdgcn_permlane32_swap(ay, by, false, false);
                u32x4 w; w.x = sx[0]; w.y = sy[0]; w.z = sx[1]; w.w = sy[1];
                E.store8(i, 32 * d0 + 16 * rp + 8 * hi, w); } }
    LDS_BAR();
}
}
__device__ __forceinline__ void rope8(const u32x4 a, const u32x4 b, const f32x4 c0, const f32x4 c1, const f32x4 s0, const f32x4 s1, bool second, float scale, u32x4& out) {
    float x1[8] = {bflo(a.x), bfhi(a.x), bflo(a.y), bfhi(a.y), bflo(a.z), bfhi(a.z), bflo(a.w), bfhi(a.w)};
    float x2[8] = {bflo(b.x), bfhi(b.x), bflo(b.y), bfhi(b.y), bflo(b.z), bfhi(b.z), bflo(b.w), bfhi(b.w)};
    const float cc[8] = {c0.x, c0.y, c0.z, c0.w, c1.x, c1.y, c1.z, c1.w}, ss[8] = {s0.x, s0.y, s0.z, s0.w, s1.x, s1.y, s1.z, s1.w};
    float y[8];
#pragma unroll
    for (int e = 0; e < 8; ++e) y[e] = (second ? (x1[e] * ss[e] + x2[e] * cc[e]) : (x1[e] * cc[e] - x2[e] * ss[e])) * scale;
    out.x = pk2(y[0], y[1]); out.y = pk2(y[2], y[3]); out.z = pk2(y[4], y[5]); out.w = pk2(y[6], y[7]);
}
__device__ __forceinline__ u32x4 scale8(const u32x4 a, float scale) {
    u32x4 o; o.x = pk2(bflo(a.x) * scale, bfhi(a.x) * scale); o.y = pk2(bflo(a.y) * scale, bfhi(a.y) * scale); o.z = pk2(bflo(a.z) * scale, bfhi(a.z) * scale); o.w = pk2(bflo(a.w) * scale, bfhi(a.w) * scale); return o;
}
__device__ __forceinline__ void seg_copy(const bf16* src, bf16* dst, int ngroups, bool rope, float scale, const f32x4 c0, const f32x4 c1, const f32x4 s0, const f32x4 s1, int lane) {
    for (int gi = lane; gi < ngroups; gi += 64) {
        const int within = gi & 7;
        if (rope && within < 2) { const u32x4 a = ldg<u32x4>(src + 8 * (gi & ~1)), b = ldg<u32x4>(src + 8 * (gi | 1)); u32x4 o; rope8(a, b, c0, c1, s0, s1, within == 1, scale, o); stg<u32x4>(dst + 8 * gi, o); }
        else { const u32x4 a = ldg<u32x4>(src + 8 * gi); stg<u32x4>(dst + 8 * gi, (scale == 1.f) ? a : scale8(a, scale)); }
    }
}
struct PSlot { int offA, offB, kind, dstride; float scale; size_t dst0; };
struct PRegs { u32x4 a, b; };
template <int NS> __device__ __forceinline__ void pslot_load(const PSlot (&S)[NS], const bf16* row, PRegs (&R)[NS]) {
#pragma unroll
    for (int i = 0; i < NS; ++i) { R[i].a = ldg<u32x4>(row + S[i].offA); R[i].b = ldg<u32x4>(row + S[i].offB); }
}
template <int NS> __device__ __forceinline__ void pslot_finish_cs(const PSlot (&S)[NS], const PRegs (&R)[NS], unsigned char* ws, int tok, size_t bcorr, const f32x4 c0, const f32x4 c1, const f32x4 s0, const f32x4 s1) {
#pragma unroll
    for (int i = 0; i < NS; ++i) { const int kind = S[i].kind; unsigned char* dp = ws + S[i].dst0 + (size_t)tok * S[i].dstride + bcorr * (kind == 7 ? 1 : 0);
        if (kind == 1 || kind == 7) { stg<u32x4>(dp, (S[i].scale == 1.f) ? R[i].a : scale8(R[i].a, S[i].scale)); }
        else if (kind == 2 || kind == 3 || kind == 8 || kind == 9) { u32x4 o; rope8(R[i].a, R[i].b, c0, c1, s0, s1, (kind & 1) != 0, S[i].scale, o); stg<u32x4>(ws + S[i].dst0 + (size_t)tok * S[i].dstride + ((kind >= 8) ? bcorr : 0), o); }
        else if (kind >= 4 && kind <= 6) { const u32x4 a = R[i].a; float v[8] = {bflo(a.x), bfhi(a.x), bflo(a.y), bfhi(a.y), bflo(a.z), bfhi(a.z), bflo(a.w), bfhi(a.w)};
#pragma unroll
            for (int e = 0; e < 8; ++e) v[e] = (kind == 4) ? v[e] * S[i].scale : 1.f / (1.f + __expf(-v[e]));
            stg<f32x4>(dp, (f32x4){v[0], v[1], v[2], v[3]}); if (kind != 6) stg<f32x4>(dp + 16, (f32x4){v[4], v[5], v[6], v[7]}); }
    }
}
__device__ __forceinline__ PSlot mk_slot(int col0, int gi, bool rope, float scale, size_t dst0, int dstride, bool compact = false) {
    PSlot p; const int within = gi & 7; const bool r = rope && within < 2;
    p.offA = col0 + 8 * (r ? (gi & ~1) : gi); p.offB = col0 + 8 * (r ? (gi | 1) : gi); p.kind = r ? (2 + within + (compact ? 6 : 0)) : (compact ? 7 : 1); p.scale = scale; p.dst0 = dst0 + 16 * (size_t)gi; p.dstride = dstride; return p;
}
__device__ __forceinline__ PSlot idle_slot() { PSlot p; p.offA = 0; p.offB = 0; p.kind = 0; p.dstride = 0; p.scale = 1.f; p.dst0 = 0; return p; }
template <int NB> __device__ __forceinline__ void pslot_run(const PSlot (&S)[1], const bf16* cols, int pitch, unsigned char* ws, int t_lo, int t_hi, const float* ct, const float* st) {
#pragma unroll 1
    for (int tok = t_lo; tok < t_hi; tok += NB) {
        PRegs R[NB][1]; f32x4 c0[NB], c1[NB], s0[NB], s1[NB];
#pragma unroll
        for (int j = 0; j < NB; ++j) { const int t = (tok + j < t_hi) ? tok + j : t_hi - 1; const int pos = t & (SEQ - 1);
            pslot_load<1>(S, cols + (size_t)t * pitch, R[j]);
            c0[j] = ldg<f32x4>(ct + pos * 8); c1[j] = ldg<f32x4>(ct + pos * 8 + 4); s0[j] = ldg<f32x4>(st + pos * 8); s1[j] = ldg<f32x4>(st + pos * 8 + 4); }
#pragma unroll
        for (int j = 0; j < NB; ++j) if (tok + j < t_hi) pslot_finish_cs<1>(S, R[j], ws, tok + j, 0, c0[j], c1[j], s0[j], s1[j]);
    }
}
__device__ __forceinline__ void dsa_post(const Ctx& C, const In& I, unsigned char* ws) {
    const bf16* cols = (const bf16*)(ws + WS_COLS); bf16* QA = (bf16*)(ws + WS_QA); bf16* QI = (bf16*)(ws + WS_QB); bf16* QM = (bf16*)(ws + WS_QM);
    bf16* K0 = (bf16*)(ws + WS_K0); bf16* V0 = (bf16*)(ws + WS_V0); bf16* KI = (bf16*)(ws + WS_KI); float* WI = (float*)(ws + WS_WI);
    const bf16* wukv = (const bf16*)(ws + WS_WUKV); const float* ct = (const float*)(ws + WS_ROPE); const float* st = ct + SEQ * 8;
    const int lane = C.lane, r32 = lane & 31, hi = lane >> 5;
    for (int blk = C.gw; blk < MTOK / 32; blk += C.ngw) {
        const int tok0 = blk * 32;
        {
            const bf16* crow = cols + (size_t)(tok0 + r32) * N0P + C0_CKV + 8 * hi;
            float xv[8][8]; float ssq = 0.f;
#pragma unroll
            for (int s8 = 0; s8 < 8; ++s8) { const u32x4 a = ldg<u32x4>(crow + 16 * s8);
                xv[s8][0] = bflo(a.x); xv[s8][1] = bfhi(a.x); xv[s8][2] = bflo(a.y); xv[s8][3] = bfhi(a.y); xv[s8][4] = bflo(a.z); xv[s8][5] = bfhi(a.z); xv[s8][6] = bflo(a.w); xv[s8][7] = bfhi(a.w);
#pragma unroll
                for (int e = 0; e < 8; ++e) ssq += xv[s8][e] * xv[s8][e]; }
            ssq = xhalf_sum(ssq);
            const float rstd = 1.f / sqrtf(ssq * (1.f / 128.f) + RMS_EPS);
            bf16x8 af[8];
#pragma unroll
            for (int s8 = 0; s8 < 8; ++s8) { const f32x4 g0 = ldg<f32x4>(I.dsa_ckv_norm + 16 * s8 + 8 * hi), g1 = ldg<f32x4>(I.dsa_ckv_norm + 16 * s8 + 8 * hi + 4);
                u32x4 w; w.x = pk2(xv[s8][0] * rstd * g0.x, xv[s8][1] * rstd * g0.y); w.y = pk2(xv[s8][2] * rstd * g0.z, xv[s8][3] * rstd * g0.w);
                w.z = pk2(xv[s8][4] * rstd * g1.x, xv[s8][5] * rstd * g1.y); w.w = pk2(xv[s8][6] * rstd * g1.z, xv[s8][7] * rstd * g1.w); af[s8] = __builtin_bit_cast(bf16x8, w); }
#pragma unroll
            for (int nt = 0; nt < 4; ++nt) {
                f32x16 acc;
#pragma unroll
                for (int r = 0; r < 16; ++r) acc[r] = 0.f;
#pragma unroll
                for (int s8 = 0; s8 < 8; ++s8) { const bf16x8 bfr = ldg<bf16x8>(wukv + (size_t)(32 * nt + r32) * 128 + 16 * s8 + 8 * hi);
                    acc = __builtin_amdgcn_mfma_f32_32x32x16_bf16(af[s8], bfr, acc, 0, 0, 0); }
                const int n = 32 * nt + r32;
#pragma unroll
                for (int r = 0; r < 16; ++r) { const int tk = tok0 + (r & 3) + 8 * (r >> 2) + 4 * hi; const bf16 hv = (bf16)(pk2(acc[r], 0.f) & 0xffffu);
                    if (nt < 2) { if (n < 48) stg<bf16>(K0 + (size_t)tk * 64 + 16 + n, hv); } else stg<bf16>(V0 + (size_t)tk * 64 + (n - 64), hv); }
            }
        }
        {
        int lane_l = lane; asm volatile("s_nop 1" : "+v"(lane_l));
        const int lane = lane_l;
        PSlot S[1];
        if (lane < 24) S[0] = mk_slot(C0_Q, 8 * (lane >> 1) + (lane & 1), true, 1.f, WS_COLS + (size_t)C0_Q * 2, N0P * 2);
        else if (lane < 40) S[0] = mk_slot(C0_QI, 8 * ((lane - 24) >> 1) + (lane & 1), true, 1.f, WS_COLS + (size_t)C0_QI * 2, N0P * 2);
        else if (lane < 42) S[0] = mk_slot(C0_KI, lane - 40, true, 1.f, WS_COLS + (size_t)C0_KI * 2, N0P * 2);
        else if (lane < 44) S[0] = mk_slot(C0_KR, lane - 42, true, 1.f, WS_K0, 64 * 2);
        else S[0] = idle_slot();
        if (lane == 44) { S[0].offA = C0_WI; S[0].offB = C0_WI; S[0].kind = 4; S[0].scale = 1.f; S[0].dst0 = WS_WI; S[0].dstride = 8 * 4; }
        pslot_run<4>(S, cols, N0P, ws, tok0, tok0 + 32, ct, st);
        }
    }
}
__device__ __forceinline__ unsigned sortkey(float f) { const unsigned u = __float_as_uint(f); return u ^ ((unsigned)((int)u >> 31) | 0x80000000u); }
__device__ __forceinline__ float unsortkey(unsigned k) { const unsigned u = (k & 0x80000000u) ? (k ^ 0x80000000u) : ~k; return __uint_as_float(u); }
__device__ __forceinline__ void dsa_index_unit(const Ctx& C, unsigned char* ws, int b, int qb) {
    const bf16* QI = (const bf16*)(ws + WS_COLS) + C0_QI; const bf16* KI = (const bf16*)(ws + WS_COLS) + C0_KI;        const float* WI = (const float*)(ws + WS_WI); unsigned* BITM = (unsigned*)(ws + WS_BITM);
    float* sc = (float*)(ws + WS_H) + (size_t)C.gw * (16 * 2048);
    const int lane = C.lane, r32 = lane & 31, hi = lane >> 5;
    const int rowbase = b * SEQ, t0 = 16 * qb, nkt = (t0 + 47) >> 5;
    {
        const int qloc = 2 * ((r32 >> 2) & 1) + (r32 >> 4), hd = 4 * ((r32 >> 3) & 1) + (r32 & 3);
#pragma unroll 1
        for (int hf = 0; hf < 2; ++hf) {
        bf16x8 qf[2][4]; float wv[2][16];
#pragma unroll
        for (int r2 = 0; r2 < 2; ++r2) { const int rt = 2 * hf + r2; const bf16* qp = QI + (size_t)(rowbase + t0 + 4 * rt + qloc) * N0P + hd * 64 + 8 * hi;
#pragma unroll
            for (int st = 0; st < 4; ++st) qf[r2][st] = ldg<bf16x8>(qp + 16 * st);
            const float* wp = WI + (size_t)(rowbase + t0 + 4 * rt + 2 * hi) * 8;
#pragma unroll
            for (int q4 = 0; q4 < 4; ++q4) { const f32x4 v = ldg<f32x4>(wp + 4 * q4); wv[r2][4 * q4] = v.x; wv[r2][4 * q4 + 1] = v.y; wv[r2][4 * q4 + 2] = v.z; wv[r2][4 * q4 + 3] = v.w; } }
        const bf16* kp0 = KI + (size_t)(rowbase + r32) * N0P + 8 * hi;
        bf16x8 ka[4], kb[4];
#pragma unroll
        for (int st = 0; st < 4; ++st) { ka[st] = ldg<bf16x8>(kp0 + 16 * st); kb[st] = ldg<bf16x8>(kp0 + (size_t)((nkt > 1) ? 1 : 0) * (32 * N0P) + 16 * st); }
#pragma unroll 1
        for (int kt = 0; kt < nkt; ++kt) {
            bf16x8 kf[4];
#pragma unroll
            for (int st = 0; st < 4; ++st) { kf[st] = ka[st]; ka[st] = kb[st]; }
            { const int kn = (kt + 2 < nkt) ? kt + 2 : kt;
#pragma unroll
              for (int st = 0; st < 4; ++st) kb[st] = ldg<bf16x8>(kp0 + (size_t)kn * (32 * N0P) + 16 * st); }
            const int key = 32 * kt + r32;
#pragma unroll
            for (int r2 = 0; r2 < 2; ++r2) { const int rt = 2 * hf + r2;
                f32x16 acc;
#pragma unroll
                for (int r = 0; r < 16; ++r) acc[r] = 0.f;
#pragma unroll
                for (int st = 0; st < 4; ++st) acc = __builtin_amdgcn_mfma_f32_32x32x16_bf16(qf[r2][st], kf[st], acc, 0, 0, 0);
                float s0 = 0.f, s1 = 0.f;
#pragma unroll
                for (int i = 0; i < 8; ++i) { s0 += __int_as_float(max(__float_as_int(acc[i]), 0)) * wv[r2][i]; s1 += __int_as_float(max(__float_as_int(acc[8 + i]), 0)) * wv[r2][8 + i]; }
                { typedef float f32x2_ __attribute__((ext_vector_type(2))); stg<f32x2_>(sc + ((size_t)(2 * rt + hi) * 2048 + key) * 2, (f32x2_){s0 + 0.f, s1 + 0.f}); }
            }
        }
        }
    }
    asm volatile("s_waitcnt vmcnt(0)" ::: "memory");
    typedef float f32x2_ __attribute__((ext_vector_type(2)));
#define IDX_LOADPAIR(dst, pr, tt) do { const float* rp_ = sc + ((size_t)(pr) * 2048 + lane) * 2; asm volatile("s_nop 1" : "+v"(rp_)); const int ngn_ = ((tt) >> 9) + 1;   \
        _Pragma("unroll") for (int g = 0; g < 4; ++g) { if (g < ngn_) { const float* rg = rp_ + 1024 * g; asm volatile("s_nop 1" : "+v"(rg)); \
            _Pragma("unroll") for (int j = 8 * g; j < 8 * g + 8; ++j) dst[j] = ldg<f32x2_>(rg + 128 * (j & 7)); } \
            else { _Pragma("unroll") for (int j = 8 * g; j < 8 * g + 8; ++j) dst[j] = (f32x2_){0.f, 0.f}; } } } while (0)
#define IDX_COUNT(cnt, key, mid, ng) do { int c4_[4] = {0, 0, 0, 0}; \
        _Pragma("unroll") for (int g = 0; g < 4; ++g) { if (g < (ng)) { _Pragma("unroll") for (int j = 8 * g; j < 8 * g + 8; ++j) c4_[j & 3] += __popcll(__ballot(key[j] >= (mid))); } } \
        cnt = (c4_[0] + c4_[1]) + (c4_[2] + c4_[3]); } while (0)
#define IDX_MASK(key, t, lo, thr, exact) do { unsigned mlo = 0u, mhi = 0u; \
        if ((t) < 256) { _Pragma("unroll") for (int j = 0; j < 32; ++j) { const unsigned long long m = __ballot(64 * j + lane <= (t)); if (lane == j) { mlo = (unsigned)m; mhi = (unsigned)(m >> 32); } } } \
        else if (exact) { _Pragma("unroll") for (int j = 0; j < 32; ++j) { const unsigned long long m = __ballot(key[j] >= (thr)); if (lane == j) { mlo = (unsigned)m; mhi = (unsigned)(m >> 32); } } } \
        else {   \
            int cgt = 0; _Pragma("unroll") for (int j = 0; j < 32; ++j) cgt += __popcll(__ballot(key[j] > (lo))); \
            int need = 256 - cgt; \
            _Pragma("unroll") for (int j = 0; j < 32; ++j) { const unsigned long long eq = __ballot(key[j] == (lo)), gt = __ballot(key[j] > (lo)); \
                const int rank = __popcll(eq & ((1ull << lane) - 1ull)); \
                const unsigned long long m = gt | __ballot(key[j] == (lo) && rank < need); need -= __popcll(eq); \
                if (lane == j) { mlo = (unsigned)m; mhi = (unsigned)(m >> 32); } } } \
        if (lane < 32) { u32x2 o; o.x = mlo; o.y = mhi; stg<u32x2>(BITM + (size_t)(rowbase + (t)) * 64 + 2 * lane, o); } } while (0)
    f32x2_ nx[32];
    IDX_LOADPAIR(nx, 0, t0 + 1);
#pragma unroll 1
    for (int qq = 0; qq < 16; qq += 2) {
        const int ta = t0 + qq, tb = ta + 1, ng = (tb >> 9) + 1;
        unsigned ka[32], kb2[32]; unsigned mina = 0xFFFFFFFFu, maxa = 0u, minb = 0xFFFFFFFFu, maxb = 0u;
#pragma unroll
        for (int j = 0; j < 32; ++j) { const int k = 64 * j + lane; const bool oka = (k <= ta), okb = (k <= tb); const unsigned sa = sortkey(nx[j].x), sb = sortkey(nx[j].y);
            ka[j] = oka ? sa : 0u; kb2[j] = okb ? sb : 0u;
            mina = oka ? (sa < mina ? sa : mina) : mina; maxa = oka ? (sa > maxa ? sa : maxa) : maxa; minb = okb ? (sb < minb ? sb : minb) : minb; maxb = okb ? (sb > maxb ? sb : maxb) : maxb; }
        if (qq < 14) IDX_LOADPAIR(nx, (qq >> 1) + 1, tb + 2);
        unsigned loa = 0u, hia = 0u, lob = 0u, hib = 0u, thra = 0u, thrb = 0u; bool exa = false, exb = false;
        if (tb >= 256) {
#pragma unroll
            for (int o = 1; o < 64; o <<= 1) { const unsigned a1 = __shfl_xor(mina, o), a2 = __shfl_xor(maxa, o), b1 = __shfl_xor(minb, o), b2 = __shfl_xor(maxb, o);
                mina = a1 < mina ? a1 : mina; maxa = a2 > maxa ? a2 : maxa; minb = b1 < minb ? b1 : minb; maxb = b2 > maxb ? b2 : maxb; }
            loa = __builtin_amdgcn_readfirstlane(mina); hia = __builtin_amdgcn_readfirstlane(maxa) + 1u; lob = __builtin_amdgcn_readfirstlane(minb); hib = __builtin_amdgcn_readfirstlane(maxb) + 1u;
            if (ta < 256) { hia = loa; }
#pragma unroll 1
            for (int it = 0; it < 64; ++it) {
                const bool acta = !exa && (hia - loa > 1u), actb = !exb && (hib - lob > 1u);
                if (!acta && !actb) break;
                unsigned mida = loa, midb = lob;
                if (it < 14) { const float fa = 0.5f * unsortkey(loa) + 0.5f * unsortkey(hia - 1u), fb = 0.5f * unsortkey(lob) + 0.5f * unsortkey(hib - 1u);
                    mida = sortkey(fa + 0.f); if (mida <= loa) mida = loa + 1u; if (mida >= hia) mida = hia - 1u;
                    midb = sortkey(fb + 0.f); if (midb <= lob) midb = lob + 1u; if (midb >= hib) midb = hib - 1u; }
                else { mida = loa + ((hia - loa) >> 1); midb = lob + ((hib - lob) >> 1); }
                int cnta = 0, cntb = 0;
                if (acta) IDX_COUNT(cnta, ka, mida, ng);
                if (actb) IDX_COUNT(cntb, kb2, midb, ng);
                if (acta) { if (cnta == 256) { thra = mida; exa = true; } else if (cnta > 256) loa = mida; else hia = mida; }
                if (actb) { if (cntb == 256) { thrb = midb; exb = true; } else if (cntb > 256) lob = midb; else hib = midb; }
            }
        }
        IDX_MASK(ka, ta, loa, thra, exa);
        IDX_MASK(kb2, tb, lob, thrb, exb);
    }
#undef IDX_LOADPAIR
#undef IDX_COUNT
#undef IDX_MASK
}
__device__ __forceinline__ void dsa_index_phase(const Ctx& C, unsigned char* ws, int vcu) {
#pragma unroll 1
    for (int i = 0; i < 2; ++i) { const int u = (i ^ ((C.gw >> 2) & 1)) ? (4095 - C.gw) : C.gw;        dsa_index_unit(C, ws, u >> 7, u & 127); }
}
__device__ __forceinline__ void dsa_attn_phase(const Ctx& C, unsigned char* ws, int vcu) {
    const bf16* QA = (const bf16*)(ws + WS_COLS) + C0_Q; const bf16* K0 = (const bf16*)(ws + WS_K0); const bf16* V0 = (const bf16*)(ws + WS_V0); const unsigned* BITM = (const unsigned*)(ws + WS_BITM);
    bf16* AO = (bf16*)(ws + WS_AO);
    const int b = vcu >> 3, s = vcu & 7, lane = C.lane, r32 = lane & 31, w = C.wave;
#pragma unroll 1
    for (int i = 0; i < 6; ++i) {
        const int qt = (i < 3) ? s : 15 - s, hg = (i < 3) ? i : i - 3;
        const int rowbase = b * SEQ, tq0w = 128 * qt + 32 * (w & 3), tq = tq0w + r32, h0 = 4 * hg + 2 * (w >> 2);
        att::Src S{K0 + (size_t)rowbase * 64, V0 + (size_t)rowbase * 64, 64, 64};
        att::EpiStore<0> E{AO, (rowbase + tq) * 1024 + h0 * 64, nullptr, 0, nullptr, 0};
        att::attn_unit<2, att::M_BITS>(C.lds, S, 0, 2 * qt + 2, QA + (size_t)(rowbase + tq) * N0P + h0 * 64, nullptr, tq, tq0w, BITM + (size_t)(rowbase + tq) * 64, 0u, E, C.tid, lane);
    }
}
__device__ __forceinline__ void mem_attn_phase(const Ctx& C, unsigned char* ws, int layer, int vcu) {
    const bf16* QM = (const bf16*)(ws + WS_COLS) + (layer ? C1_QM : C0_QM); const int qmp = layer ? N1P : N0P;        const bf16* MKV = (const bf16*)(ws + WS_MEMKV) + (size_t)layer * BATCH * NMEM * 512; bf16* AO = (bf16*)(ws + WS_AO);
    const int lane = C.lane, r32 = lane & 31, w = C.wave;
#pragma unroll 1
    for (int i = 0; i < 4; ++i) {
        const int u = vcu * 4 + i, b = u >> 5, h = (u >> 3) & 3, qt = u & 7;
        const int rowbase = b * SEQ, tq0w = 256 * qt + 32 * w, tq = tq0w + r32;
        att::Src S{MKV + (size_t)b * NMEM * 512 + h * 64, MKV + (size_t)b * NMEM * 512 + 256 + h * 64, 512, 512};
        att::EpiStore<0> E{AO, (rowbase + tq) * 1024 + 768 + h * 64, nullptr, 0, nullptr, 0};
        att::attn_unit<1, att::M_NONE>(C.lds, S, 0, 4, QM + (size_t)(rowbase + tq) * qmp + h * 64, nullptr, tq, tq0w, nullptr, 0u, E, C.tid, lane);
    }
}
__device__ __forceinline__ void nsa_post(const Ctx& C, unsigned char* ws) {
    const bf16* cols = (const bf16*)(ws + WS_COLS); const float* ct = (const float*)(ws + WS_ROPE); const float* st = ct + SEQ * 8; const int lane = C.lane;
    PSlot S[1];
    if (lane < 24) { const int hd = lane >> 1, hf = lane & 1; S[0].offA = C1_Q + 64 * hd; S[0].offB = S[0].offA + 8; S[0].kind = 2 + hf; S[0].scale = 1.f; S[0].dst0 = WS_QB + (size_t)(32 * hd + 16 * hf); S[0].dstride = 192 * 2; }
    else if (lane < 32) { const int l = lane - 24, kw = l >> 2, g = (l >> 1) & 1, hf = l & 1; const int col = (kw ? C1_KW : C1_KS) + 64 * g;
        S[0].offA = col; S[0].offB = col + 8; S[0].kind = 2 + hf; S[0].scale = 1.f; S[0].dst0 = WS_COLS + (size_t)(col + 8 * hf) * 2; S[0].dstride = N1P * 2; }
    else if (lane < 37) { const int j = lane - 32; S[0].offA = C1_G + 8 * j; S[0].offB = S[0].offA; S[0].kind = (j < 4) ? 5 : 6; S[0].scale = 1.f; S[0].dst0 = WS_GATES + 32 * (size_t)j; S[0].dstride = 36 * 4; }
    else S[0] = idle_slot();
    const int per = (MTOK + C.ngw - 1) / C.ngw, t_lo = C.gw * per, t_hi = (t_lo + per < MTOK) ? t_lo + per : MTOK;
    if (t_lo >= t_hi) return;
    pslot_run<4>(S, cols, N1P, ws, t_lo, t_hi, ct, st);
}
__device__ __forceinline__ float gelu_tanh(float x) { const float y = 0.7978845608028654f * (x + 0.044715f * x * x * x); const float e = __builtin_amdgcn_exp2f(2.885390081777927f * y); return 0.5f * x * (2.f - 2.f * __builtin_amdgcn_rcpf(e + 1.f)); }
__device__ __forceinline__ void nsa_compress_unit(const Ctx& C, unsigned char* ws, int u) {
    const int rt = u & 3, kv = (u >> 2) & 1, g = (u >> 3) & 1, b = u >> 4;
    const bf16* SRC = (const bf16*)(ws + WS_COLS) + (size_t)b * SEQ * N1P + (kv ? C1_VC : C1_KC) + g * 64; const bf16* W1 = (const bf16*)(ws + WS_WC1) + (size_t)kv * 128 * 2048;
    const bf16* W2 = (const bf16*)(ws + WS_WC2) + (size_t)kv * 64 * 128; const float* pb = (const float*)(ws + WS_CMPB);
    bf16* DST = (bf16*)(ws + (kv ? WS_VCMP : WS_KCMP)) + (size_t)(b * 2 + g) * 128 * 64;
    const int lane = C.lane, r32 = lane & 31, hi = lane >> 5, w = C.wave, ct = w & 3, kh = w >> 2;
    LAS float* red = (LAS float*)C.lds;
    LAS unsigned char* hb = C.lds + 16384;
    int cblk = 32 * rt + r32; if (cblk > 126) cblk = 126;
    const bf16* ap = SRC + (size_t)(16 * cblk + 16 * kh) * N1P + 8 * hi; const bf16* bp        = W1 + (size_t)(32 * ct + r32) * 2048 + 1024 * kh + 8 * hi;
    f32x16 acc;
#pragma unroll
    for (int r = 0; r < 16; ++r) acc[r] = 0.f;
    {   bf16x8 a[8], bb[8], an[8], bn[8];
#define CMP_LD(A_, B_, s0_) do { _Pragma("unroll") for (int j = 0; j < 8; ++j) { A_[j] = ldg<bf16x8>(ap + (size_t)(((s0_) + j) >> 2) * N1P + 16 * (((s0_) + j) & 3)); B_[j] = ldg<bf16x8>(bp + 16 * ((s0_) + j)); } asm volatile("" ::: "memory"); } while (0)
#define CMP_MM(A_, B_) do { _Pragma("unroll") for (int j = 0; j < 8; ++j) acc = __builtin_amdgcn_mfma_f32_32x32x16_bf16(A_[j], B_[j], acc, 0, 0, 0); asm volatile("" ::: "memory"); } while (0)
        CMP_LD(a, bb, 0);
#pragma unroll 1
        for (int s0 = 0; s0 < 64; s0 += 16) {
            CMP_LD(an, bn, s0 + 8);
            CMP_MM(a, bb);
            { const int sn = (s0 + 16 < 64) ? s0 + 16 : 0; CMP_LD(a, bb, sn); }
            CMP_MM(an, bn);
        }
#undef CMP_LD
#undef CMP_MM
    }
    if (kh == 1) {
#pragma unroll
        for (int r = 0; r < 16; ++r) red[(ct * 16 + r) * 64 + lane] = acc[r]; }
    LDS_BAR();
    if (kh == 0) { float bias = 0.f; { const int n = 32 * ct + r32; const float* bp2 = pb + (size_t)((kv * 2 + (n >> 6)) * 32) * 64 + (n & 63);
#pragma unroll
            for (int kc = 0; kc < 32; ++kc) bias += ldg<float>(bp2 + kc * 64); }
#pragma unroll
        for (int r = 0; r < 16; ++r) { const float hv = gelu_tanh(acc[r] + red[(ct * 16 + r) * 64 + lane] + bias); const int crow = (r & 3) + 8 * (r >> 2) + 4 * hi;
            *(LAS bf16*)(hb + crow * 272 + (32 * ct + r32) * 2) = (bf16)(pk2(hv, 0.f) & 0xffffu); } }
    LDS_BAR();
    if (w < 2) {
        f32x16 o2;
#pragma unroll
        for (int r = 0; r < 16; ++r) o2[r] = 0.f;
#pragma unroll
        for (int s8 = 0; s8 < 8; ++s8) { const bf16x8 a = *(const LAS bf16x8*)(hb + r32 * 272 + (16 * s8 + 8 * hi) * 2); const bf16x8 bb = ldg<bf16x8>(W2 + (size_t)(32 * w + r32) * 128 + 16 * s8 + 8 * hi);
            o2 = __builtin_amdgcn_mfma_f32_32x32x16_bf16(a, bb, o2, 0, 0, 0); }
#pragma unroll
        for (int r = 0; r < 16; ++r) { const int crow = 32 * rt + (r & 3) + 8 * (r >> 2) + 4 * hi; stg<bf16>(DST + (size_t)crow * 64 + 32 * w + r32, (crow < 127) ? (bf16)(pk2(o2[r], 0.f) & 0xffffu) : (bf16)0); }
    }
    LDS_BAR();
}
__device__ __forceinline__ void nsa_cmp_unit(const Ctx& C, unsigned char* ws, int u) {
    const int qt = u & 7, g = (u >> 3) & 1, b = u >> 4;
    const bf16* QA = (const bf16*)(ws + WS_COLS) + C1_Q; const bf16* KCMP = (const bf16*)(ws + WS_KCMP) + (size_t)(b * 2 + g) * 128 * 64; const bf16* VCMP = (const bf16*)(ws + WS_VCMP) + (size_t)(b * 2 + g) * 128 * 64;
    const float* GT = (const float*)(ws + WS_GATES); bf16* OC = (bf16*)(ws + WS_OC); unsigned* SELM = (unsigned*)(ws + WS_SELM);
    const int lane = C.lane, r32 = lane & 31, hi = lane >> 5, w = C.wave, tid = C.tid;
    constexpr int KSTR = 144; LAS unsigned char* kb = C.lds; LAS unsigned char* vb = C.lds + 128 * KSTR;
    for (int i = tid; i < 1024; i += 512) { const int row = i >> 3, ch = i & 7;
        *(LAS u32x4*)(kb + row * KSTR + ch * 16) = ldg<u32x4>(KCMP + row * 64 + ch * 8);
        *(LAS u32x4*)(vb + (ch >> 2) * 8192 + row * 64 + (ch & 3) * 16) = ldg<u32x4>(VCMP + row * 64 + ch * 8); }
    LDS_BAR();
    const int rowbase = b * SEQ, tq = 256 * qt + 32 * w + r32, tok = rowbase + tq;
    const int cmax = (tq - 31) >> 4;
    const int koff = r32 * KSTR + hi * 16, voff = ((lane >> 4) & 1) * 32 + (lane & 3) * 8 + (4 * hi + ((lane & 15) >> 2)) * 64;
    float A[16], B[16];
#pragma unroll
    for (int m8 = 0; m8 < 16; ++m8) { A[m8] = 0.f; B[m8] = 0.f; }
#pragma unroll 1
    for (int j = 0; j < 6; ++j) { const int h = g * 6 + j; const bf16* qp = QA + (size_t)tok * N1P + h * 64 + 8 * hi;
        bf16x8 qf[4];
#pragma unroll
        for (int st = 0; st < 4; ++st) qf[st] = ldg<bf16x8>(qp + 16 * st);
        f32x16 s[4]; float mx = -INFINITY;
#pragma unroll
        for (int sb = 0; sb < 4; ++sb) {
#pragma unroll
            for (int r = 0; r < 16; ++r) s[sb][r] = 0.f;
#pragma unroll
            for (int st = 0; st < 4; ++st) { const bf16x8 kf = *(const LAS bf16x8*)(kb + koff + sb * 32 * KSTR + st * 32); s[sb] = __builtin_amdgcn_mfma_f32_32x32x16_bf16(kf, qf[st], s[sb], 0, 0, 0); }
#pragma unroll
            for (int r = 0; r < 16; ++r) { const int c = 32 * sb + 4 * hi + ATT_C(r); s[sb][r] = (c <= cmax) ? s[sb][r] : -INFINITY; mx = fmaxf(mx, s[sb][r]); } }
        mx = xhalf_max(mx); const float mref = (mx == -INFINITY) ? 0.f : mx;
        float ls = 0.f;
#pragma unroll
        for (int sb = 0; sb < 4; ++sb)
#pragma unroll
            for (int r = 0; r < 16; ++r) { s[sb][r] = __builtin_amdgcn_exp2f(s[sb][r] - mref); ls += s[sb][r]; }
        ls = xhalf_sum(ls); const float inv = 1.f / fmaxf(ls, 1e-30f);
        bf16x8 pa[8];
#pragma unroll
        for (int sb = 0; sb < 4; ++sb) {
#pragma unroll
            for (int r = 0; r < 16; ++r) s[sb][r] *= inv;
#pragma unroll
            for (int q4 = 0; q4 < 4; ++q4) { const int m8 = 4 * sb + q4; A[m8] += s[sb][4 * q4] + s[sb][4 * q4 + 1] + s[sb][4 * q4 + 2] + 0.5f * s[sb][4 * q4 + 3]; B[m8] += 0.5f * s[sb][4 * q4 + 3]; }
            u32x4 p0, p1;
            p0.x = pk2(s[sb][0], s[sb][1]); p0.y = pk2(s[sb][2], s[sb][3]); p0.z = pk2(s[sb][4], s[sb][5]); p0.w = pk2(s[sb][6], s[sb][7]);
            p1.x = pk2(s[sb][8], s[sb][9]); p1.y = pk2(s[sb][10], s[sb][11]); p1.z = pk2(s[sb][12], s[sb][13]); p1.w = pk2(s[sb][14], s[sb][15]);
            pa[2 * sb] = __builtin_bit_cast(bf16x8, p0); pa[2 * sb + 1] = __builtin_bit_cast(bf16x8, p1); }
        __builtin_amdgcn_sched_barrier(0);
        f32x16 o[2];
#pragma unroll
        for (int r = 0; r < 16; ++r) { o[0][r] = 0.f; o[1][r] = 0.f; }
#pragma unroll
        for (int sb = 0; sb < 4; ++sb) {
#pragma unroll
            for (int d0 = 0; d0 < 2; ++d0) { const LAS unsigned char* vp = vb + voff + d0 * 8192 + (32 * sb) * 64;
                const s16x4 a0 = att::vtr(vp), b0 = att::vtr(vp + 8 * 64), a1 = att::vtr(vp + 16 * 64), b1 = att::vtr(vp + 24 * 64);
                o[d0] = __builtin_amdgcn_mfma_f32_32x32x16_bf16((bf16x8){a0[0], a0[1], a0[2], a0[3], b0[0], b0[1], b0[2], b0[3]}, pa[2 * sb], o[d0], 0, 0, 0);
                o[d0] = __builtin_amdgcn_mfma_f32_32x32x16_bf16((bf16x8){a1[0], a1[1], a1[2], a1[3], b1[0], b1[1], b1[2], b1[3]}, pa[2 * sb + 1], o[d0], 0, 0, 0); } }
        const float g0 = ldg<float>(GT + (size_t)tok * 36 + h * 3); bf16* orow = OC + (size_t)tok * 768 + h * 64;
#pragma unroll
        for (int d0 = 0; d0 < 2; ++d0)
#pragma unroll
            for (int rp = 0; rp < 2; ++rp) { const int r0 = 8 * rp;
                const unsigned ax = pk2(o[d0][r0] * g0, o[d0][r0 + 1] * g0), ay = pk2(o[d0][r0 + 2] * g0, o[d0][r0 + 3] * g0);
                const unsigned bx = pk2(o[d0][r0 + 4] * g0, o[d0][r0 + 5] * g0), by = pk2(o[d0][r0 + 6] * g0, o[d0][r0 + 7] * g0);
                const auto sx = __builtin_amdgcn_permlane32_swap(ax, bx, false, false); const auto sy = __builtin_amdgcn_permlane32_swap(ay, by, false, false);
                u32x4 wv; wv.x = sx[0]; wv.y = sy[0]; wv.z = sx[1]; wv.w = sy[1];
                stg<u32x4>(orow + 32 * d0 + 16 * rp + 8 * hi, wv); }
    }
    float A0[16], A1[16], B0[16], B1[16];
#pragma unroll
    for (int m8 = 0; m8 < 16; ++m8) {
        const auto ra = __builtin_amdgcn_permlane32_swap(__float_as_uint(A[m8]), __float_as_uint(A[m8]), false, false);
        const auto rb = __builtin_amdgcn_permlane32_swap(__float_as_uint(B[m8]), __float_as_uint(B[m8]), false, false);
        A0[m8] = __uint_as_float(ra[0]); A1[m8] = __uint_as_float(ra[1]); B0[m8] = __uint_as_float(rb[0]); B1[m8] = __uint_as_float(rb[1]); }
    float imp[32];
#pragma unroll
    for (int m8 = 0; m8 < 16; ++m8) { imp[2 * m8] = (m8 > 0) ? (A0[m8] + B1[m8 - 1]) : A0[0]; imp[2 * m8 + 1] = B0[m8] + A1[m8]; }
    const int cur = tq >> 6; unsigned sel;
    if (cur < 16) sel = (2u << cur) - 1u;
    else { sel = 1u | (1u << cur) | (1u << (cur - 1));
#pragma unroll
        for (int n = 1; n < 30; ++n) { int rank = 0;
#pragma unroll
            for (int n2 = 1; n2 < 30; ++n2) { if (n2 == n) continue; const bool ahead = (imp[n2] > imp[n]) || (imp[n2] == imp[n] && n2 < n); rank += (ahead && n2 <= cur - 2) ? 1 : 0; }
            if (n <= cur - 2 && rank < 13) sel |= 1u << n; } }
    if (hi == 0) stg<unsigned>(SELM + (size_t)tok * 2 + g, sel);
    LDS_BAR();
}
__device__ __forceinline__ void nsa_attn_phase(const Ctx& C, unsigned char* ws, int vcu) {
    const bf16* QR = (const bf16*)(ws + WS_QB); const bf16* cols = (const bf16*)(ws + WS_COLS);
    const float* GT = (const float*)(ws + WS_GATES); const bf16* OC = (const bf16*)(ws + WS_OC); const unsigned* SELM = (const unsigned*)(ws + WS_SELM); bf16* AO = (bf16*)(ws + WS_AO);
    const int b = vcu >> 3, g = (vcu >> 2) & 1, s = vcu & 3, lane = C.lane, r32 = lane & 31, w = C.wave;
#pragma unroll 1
    for (int i = 0; i < 6; ++i) {
        const int qt = (i < 3) ? s : 7 - s, hp = (i < 3) ? i : i - 3;
        const int rowbase = b * SEQ, tq0w = 256 * qt + 32 * w, tq = tq0w + r32, h0 = 6 * g + 2 * hp, tok = rowbase + tq;
        const bf16* qrow = cols + (size_t)tok * N1P + C1_Q + h0 * 64; const bf16* qrot = QR + (size_t)tok * 192 + h0 * 16; const int ooff = tok * 1024 + h0 * 64;
        {   att::Src S{cols + (size_t)rowbase * N1P + C1_KS + g * 64, cols + (size_t)rowbase * N1P + C1_VS + g * 64, N1P, N1P};
            att::EpiStore<1> E{AO, ooff, GT, tok * 36 + h0 * 3 + 1, nullptr, 0};
            att::attn_unit<2, att::M_BLOCK>(C.lds, S, 0, 4 * qt + 4, qrow, qrot, tq, tq0w, nullptr, ldg<unsigned>(SELM + (size_t)tok * 2 + g), E, C.tid, lane); }
        {   att::Src S{cols + (size_t)rowbase * N1P + C1_KW + g * 64, cols + (size_t)rowbase * N1P + C1_VW + g * 64, N1P, N1P};
            att::EpiStore<2> E{AO, ooff, GT, tok * 36 + h0 * 3 + 2, OC, tok * 768 + h0 * 64};
            const int lo = (4 * qt - 8 > 0) ? 4 * qt - 8 : 0;
            att::attn_unit<2, att::M_WIN>(C.lds, S, lo, 4 * qt + 4, qrow, qrot, tq, tq0w, nullptr, 0u, E, C.tid, lane); }
    }
}
#ifndef MK_N_LAUNCHES
#define MK_N_LAUNCHES 1
#endif
constexpr int NPH = 20;
struct Args { In in; float* out; unsigned char* ws; int ph_lo, ph_hi; };
template <class Epi>
__device__ __forceinline__ void run_gemm(LAS unsigned char* lds, const bf16* A, const bf16* Bt, int M, int N, int K, const Epi& E) {
    pg8::Gemm g{A, Bt, M, N, K}; pg8::StaticOrder S; S.init(M, N, (int)gridDim.x, (int)blockIdx.x);
    pg8::gemm_phase<Epi, pg8::StaticOrder, true, true>(lds, g, S, E);
}
__device__ __forceinline__ const LAS float* wg_rstd_panels(LAS unsigned char* lds, const unsigned char* ws, int M, int N) {
    pg8::StaticOrder S; S.init(M, N, (int)gridDim.x, (int)blockIdx.x);
    LAS float* rl = (LAS float*)(lds + MISC_OFF + 4096);
    const float* part = (const float*)(ws + WS_PART);
    unsigned done = 0u; pg8::Unit u;
    for (int i = 0; S.next(i, u); ++i) { const int slot = (u.pm >> 3) & 3;
        if ((done >> slot) & 1u) continue;
        done |= 1u << slot;
        if (threadIdx.x < 256) { const int row = u.pm * 256 + (int)threadIdx.x; const f32x4* p = (const f32x4*)(part + (size_t)row * 16);
            const f32x4 a = ldg<f32x4>(p), b = ldg<f32x4>(p + 1), c = ldg<f32x4>(p + 2), d = ldg<f32x4>(p + 3);
            const float ss = ((a.x + a.y) + (a.z + a.w)) + ((b.x + b.y) + (b.z + b.w)) + ((c.x + c.y) + (c.z + c.w)) + ((d.x + d.y) + (d.z + d.w));
            rl[slot * 256 + (int)threadIdx.x] = 1.f / sqrtf(ss * (1.f / DM) + RMS_EPS); } }
    __syncthreads();
    return rl;
}
__device__ __forceinline__ Ctx mkctx(LAS unsigned char* lds, int vcu, int G) {
    Ctx C; int t = threadIdx.x; asm volatile("s_nop 1" : "+v"(t)); C.lds = lds; C.tid = t; C.lane = t & 63; C.wave = __builtin_amdgcn_readfirstlane(t >> 6); C.gw = vcu * NWAVES + C.wave; C.ngw = G * NWAVES; return C; }
#define WSP() ({ GAS unsigned char* p_ = (GAS unsigned char*)args.ws; asm volatile("s_nop 4" : "+s"(p_)); (unsigned char*)p_; })
__global__ void __launch_bounds__(NWAVES * 64, 2) mk_fwd(Args args) {
    extern __shared__ __attribute__((aligned(16))) unsigned char lds_raw[];
    LAS unsigned char* lds = (LAS unsigned char*)lds_raw;
    volatile LAS unsigned* MISC = (volatile LAS unsigned*)(lds + MISC_OFF);
    const int G = gridDim.x, bx = blockIdx.x; const int vcu = (G % 8 == 0) ? (bx % 8) * (G / 8) + bx / 8 : bx;
    for (int u = threadIdx.x; u < (LDS_BYTES - MISC_OFF) / 4; u += NWAVES * 64) ((LAS unsigned*)(lds + MISC_OFF))[u] = 0u;
    __syncthreads();
    unsigned* barw = (unsigned*)(args.ws + WS_CTL) + CW_BAR;
    XcdBarrier bar; bar.bar = barw; bar.x = 0; bar.st = nullptr;
    if (MK_N_LAUNCHES == 1) bar = xcd_barrier_post(barw, MISC + 8);
#if MK_N_LAUNCHES == 1
    constexpr int lo = 0; const int hi = args.ph_hi;
#else
    const int lo = args.ph_lo, hi = args.ph_hi;
#endif
#ifndef PH_MASK
#define PH_MASK 0xFFFFFu
#endif
#define IN(k) (((PH_MASK >> ((k) >= 15 ? (k) - 10 : (k))) & 1u) && lo <= (k) && (k) < hi)
#ifndef REP_MASK
#define REP_MASK 0u
#endif
#define REPS(k) _Pragma("unroll 1") for (int rep_ = 0; rep_ < 1 + (int)((REP_MASK >> (k)) & 1u); ++rep_)
#define SEAM(k) do { if (IN(k) && IN((k) + 1)) { XcdBarrier b_ = bar; asm volatile("s_nop 4" : "+s"(b_.x)); xcd_barrier(b_); } } while (0)
    if (IN(0)) REPS(0) { const Ctx C = mkctx(lds, vcu, G); p0_prologue(C, args.in, WSP()); } SEAM(0);
    if (IN(1)) { unsigned char* ws = WSP();
        run_gemm(lds, (const bf16*)(ws + WS_H), (const bf16*)(ws + WS_WIN0), MTOK, N0P, DM, pg8::EpiStoreBf16{(bf16*)(ws + WS_COLS), N0P, (const LAS float*)(lds + MISC_OFF + 4096), 0});
        run_gemm(lds, (const bf16*)(ws + WS_MEMN), (const bf16*)(ws + WS_WMKV), 2 * BATCH * NMEM, 2 * 512, DM, pg8::EpiMemKV{(bf16*)(ws + WS_MEMKV), 512, BATCH * NMEM});
    } SEAM(1);
    if (IN(2)) REPS(2) { const Ctx C = mkctx(lds, vcu, G); dsa_post(C, args.in, WSP()); } SEAM(2);
    if (IN(3)) REPS(3) { const Ctx C = mkctx(lds, vcu, G); if (G == 256) dsa_index_phase(C, WSP(), vcu); } SEAM(3);
    if (IN(4)) REPS(4) { if (G == 256) {
#ifndef DBG_SKIP_DSA_ATTN
            { const Ctx C = mkctx(lds, vcu, G); dsa_attn_phase(C, WSP(), vcu); }
#endif
#ifndef DBG_SKIP_MEM_ATTN
            { const Ctx C = mkctx(lds, vcu, G); mem_attn_phase(C, WSP(), 0, vcu); }
#endif
        } } SEAM(4);
#pragma unroll 1
    for (int layer = 0; layer < 2; ++layer) {
        const int pb = 5 + 10 * layer;
        if (layer == 1) {
            if (IN(10)) { unsigned char* ws = WSP(); const LAS float* rl = wg_rstd_panels(lds, ws, MTOK, N1P); run_gemm(lds, (const bf16*)args.out + (size_t)MTOK * DM  , (const bf16*)(ws + WS_WIN1), MTOK, N1P, DM, pg8::EpiStoreBf16{(bf16*)(ws + WS_COLS), N1P, rl, 1}); } SEAM(10);
            if (IN(11)) REPS(11) { const Ctx C = mkctx(lds, vcu, G); nsa_post(C, WSP()); }
            if (IN(12)) REPS(12) { const Ctx C = mkctx(lds, vcu, G); unsigned char* ws = WSP(); for (int u = vcu; u < 512; u += G) nsa_compress_unit(C, ws, u); } SEAM(12);
            if (IN(13)) REPS(13) { { const Ctx C = mkctx(lds, vcu, G); unsigned char* ws = WSP(); for (int u = vcu; u < 512; u += G) nsa_cmp_unit(C, ws, u); }
                          if (G == 256) { const Ctx C = mkctx(lds, vcu, G); mem_attn_phase(C, WSP(), 1, vcu); } } SEAM(13);
            if (IN(14)) REPS(14) { const Ctx C = mkctx(lds, vcu, G); if (G == 256) nsa_attn_phase(C, WSP(), vcu); } SEAM(14);
        }
        if (IN(pb)) { unsigned char* ws = WSP(); bf16* RS = (bf16*)args.out + (size_t)MTOK * DM;
            run_gemm(lds, (const bf16*)(ws + WS_AO), (const bf16*)(ws + WS_WO) + (size_t)layer * DM * DM, MTOK, DM, DM,
                     pg8::EpiResNormB{layer == 0 ? (const void*)args.in.x : (const void*)RS, layer, RS, DM, (float*)(ws + WS_PART)}); } SEAM(pb);
        if (IN(pb + 2)) REPS(7) { unsigned char* ws = WSP(); const LAS float* rl = wg_rstd_panels(lds, ws, MTOK, 2 * DFF); run_gemm(lds, (const bf16*)args.out + (size_t)MTOK * DM, (const bf16*)(ws + WS_WFI) + (size_t)layer * 2 * DFF * DM, MTOK, 2 * DFF, DM, pg8::EpiSwiGLU{(bf16*)(ws + WS_HID), DFF, rl}); } SEAM(pb + 2);
        if (IN(pb + 3)) { unsigned char* ws = WSP(); bf16* RS = (bf16*)args.out + (size_t)MTOK * DM;
            run_gemm(lds, (const bf16*)(ws + WS_HID), (const bf16*)(ws + WS_WFD) + (size_t)layer * DM * DFF, MTOK, DM, DFF,
                     pg8::EpiResNormB{RS, 1, layer == 0 ? RS : (bf16*)(ws + WS_H), DM, layer == 0 ? (float*)(ws + WS_PART) : (float*)nullptr}); } SEAM(pb + 3);
    }
    if (IN(19)) { const Ctx C = mkctx(lds, vcu, G); final_norm_rows(C, (const bf16*)(WSP() + WS_H), args.in.final_norm, args.out, MTOK); }
#undef IN
#undef SEAM
}
extern "C" void kernel_launch(void* const* d_in, const int* in_sizes, int n_in, void* d_out, int out_size, void* d_ws, size_t ws_size, hipStream_t stream) {
    static int grid = 0;
    if (grid == 0) {
        if (n_in != 21 || out_size != MTOK * DM || ws_size < WS_END) { fprintf(stderr, "kernel_launch: unexpected problem (n_in %d, out %d, ws %zu)\n", n_in, out_size, ws_size); grid = -1; return; }
        int dev = 0, cus = 0, per_cu = 0;
        if (hipGetDevice(&dev) != hipSuccess || hipDeviceGetAttribute(&cus, hipDeviceAttributeMultiprocessorCount, dev) != hipSuccess) { grid = -1; return; }
        if (hipFuncSetAttribute((const void*)mk_fwd, hipFuncAttributeMaxDynamicSharedMemorySize, LDS_BYTES) != hipSuccess) { fprintf(stderr, "kernel_launch: hipFuncSetAttribute failed\n"); grid = -1; return; }
        if (hipOccupancyMaxActiveBlocksPerMultiprocessor(&per_cu, (const void*)mk_fwd, NWAVES * 64, LDS_BYTES) != hipSuccess || per_cu < 1) fprintf(stderr, "kernel_launch: occupancy query says %d\n", per_cu);
        (void)hipGetLastError();
        grid = cus;
    }
    if (grid < 0) return;
    if (hipMemsetAsync((char*)d_ws + WS_CTL, 0, CTL_ZERO_BYTES, stream) != hipSuccess) return;
#ifdef DBG_ZERO_AO
    (void)hipMemsetAsync((char*)d_ws + WS_AO, 0, (size_t)MTOK * DM * 2, stream);
#endif
    Args a{};
    const float** ip = (const float**)&a.in;
    for (int i = 0; i < 21; ++i) ip[i] = (const float*)d_in[i];
    a.out = (float*)d_out; a.ws = (unsigned char*)d_ws;
#if MK_N_LAUNCHES == 1
    a.ph_lo = 0; a.ph_hi = NPH;
    hipLaunchKernelGGL(mk_fwd, dim3(grid), dim3(NWAVES * 64), LDS_BYTES, stream, a);
#else
    for (int p = 0; p < NPH; ++p) { a.ph_lo = p; a.ph_hi = p + 1; hipLaunchKernelGGL(mk_fwd, dim3(grid), dim3(NWAVES * 64), LDS_BYTES, stream, a); }
#endif
}
```
